# Optimizing an MI355X kernel written in HIP

```python
import jax, jax.numpy as jnp
from jax import lax
import numpy as np

D_MODEL = 4096
BATCH = 1
SEQ = 8192
DEPTH = 1

D_MIX = D_MODEL
D_GLA = D_MIX // 2
GLA_HEADS = 8
GLA_DV = D_GLA // GLA_HEADS
GLA_DK = GLA_DV // 2
GLA_KEY = GLA_HEADS * GLA_DK
GLA_GATE_RANK = 16
GLA_GATE_NORMALIZER = 16.0
D_HGRN = D_MIX - D_GLA
HGRN_EXPAND = 128
HGRN_HEADS = D_HGRN // HGRN_EXPAND
CHUNK = 64
N_EXPERTS = 16
D_EXPERT = 2048
CAPACITY_FACTOR = 2
EPS = 1e-6

SPLIT_SIZES = (
    GLA_KEY,
    GLA_KEY,
    D_GLA,
    GLA_GATE_RANK,
    GLA_GATE_RANK,
    D_GLA,
    D_HGRN,
    D_HGRN,
    D_HGRN,
    D_HGRN,
    D_HGRN,
)
D_IN_PROJ = sum(SPLIT_SIZES)

kernel_name = "hybrid_gla_hgrn2_ecmoe_encoder"


def rms_norm(x, w):
    xf = x.astype(jnp.float32)
    y = xf * lax.rsqrt(jnp.mean(xf * xf, axis=-1, keepdims=True) + EPS)
    return (y * w.astype(jnp.float32)).astype(x.dtype)


def to_heads(t, n_heads):
    b, l, hd = t.shape
    return t.reshape(b, l, n_heads, hd // n_heads).transpose(0, 2, 1, 3)


def from_heads(t):
    b, h, l, d = t.shape
    return t.transpose(0, 2, 1, 3).reshape(b, l, h * d)


def chunk_gated_linear_scan(q, k, v, log_a):
    b, h, l, dk = q.shape
    dv = v.shape[-1]
    n_chunks = l // CHUNK

    def chunks(t):
        return t.reshape(b, h, n_chunks, CHUNK, t.shape[-1]).transpose(2, 0, 1, 3, 4)

    lower = jnp.tril(jnp.ones((CHUNK, CHUNK), dtype=bool))

    def step(state, inp):
        qc, kc, vc, gc = (t.astype(jnp.float32) for t in inp)
        cum = jnp.cumsum(gc, axis=2)
        o_inter = jnp.einsum('bhtd,bhde->bhte', qc * jnp.exp(cum), state)
        rel = cum[:, :, :, None, :] - cum[:, :, None, :, :]
        decay = jnp.exp(jnp.where(lower[None, None, :, :, None], rel, -jnp.inf))
        scores = jnp.einsum('bhtd,bhsd,bhtsd->bhts', qc, kc, decay)
        o_intra = jnp.einsum('bhts,bhse->bhte', scores, vc)
        last = cum[:, :, -1:, :]
        k_dec = kc * jnp.exp(last - cum)
        new_state = (jnp.exp(last[:, :, 0, :])[..., None] * state
                     + jnp.einsum('bhsd,bhse->bhde', k_dec, vc))
        return new_state, o_inter + o_intra

    state0 = jnp.zeros((b, h, dk, dv), jnp.float32)
    _, o = lax.scan(step, state0, (chunks(q), chunks(k), chunks(v), chunks(log_a)))
    return o.transpose(1, 2, 0, 3, 4).reshape(b, h, l, dv).astype(v.dtype)


def bidirectional_scan(q, k_fwd, k_bwd, v, log_a_fwd, log_a_bwd):
    flip = lambda t: jnp.flip(t, axis=2)
    fwd = chunk_gated_linear_scan(q, k_fwd, v, log_a_fwd)
    bwd = flip(chunk_gated_linear_scan(flip(q), flip(k_bwd), flip(v), flip(log_a_bwd)))
    return fwd + bwd


def gla_group(q, k, v, gate_low_f, gate_low_b, og,
              up_f, bias_f, up_b, bias_b, norm_w):
    log_a_f = jax.nn.log_sigmoid(gate_low_f @ up_f + bias_f) / GLA_GATE_NORMALIZER
    log_a_b = jax.nn.log_sigmoid(gate_low_b @ up_b + bias_b) / GLA_GATE_NORMALIZER
    qh = to_heads(q, GLA_HEADS) * (GLA_DK ** -0.5)
    kh = to_heads(k, GLA_HEADS)
    vh = to_heads(v, GLA_HEADS)
    o = bidirectional_scan(qh, kh, kh, vh,
                           to_heads(log_a_f, GLA_HEADS), to_heads(log_a_b, GLA_HEADS))
    o = rms_norm(o, norm_w) * jax.nn.silu(to_heads(og, GLA_HEADS))
    return from_heads(o)


def hgrn2_group(q, f_raw_f, f_raw_b, i, og, lb_f, lb_b, norm_w):
    def gates(f_raw, lb):
        k = (1.0 - lb) * jax.nn.sigmoid(-f_raw)
        log_f = jnp.log(lb + (1.0 - lb) * jax.nn.sigmoid(f_raw))
        return to_heads(k, HGRN_HEADS), to_heads(log_f, HGRN_HEADS)
    k_f, log_f_f = gates(f_raw_f, lb_f)
    k_b, log_f_b = gates(f_raw_b, lb_b)
    qh = to_heads(jax.nn.silu(q), HGRN_HEADS) * (HGRN_EXPAND ** -0.5)
    ih = to_heads(i, HGRN_HEADS)
    o = bidirectional_scan(qh, k_f, k_b, ih, log_f_f, log_f_b)
    o = rms_norm(o, norm_w) * jax.nn.silu(to_heads(og, HGRN_HEADS))
    return from_heads(o)


def expert_choice_ffn(x, w_router, w1, w3, w2):
    b, n, d = x.shape
    cap = CAPACITY_FACTOR * n // N_EXPERTS
    affinity = jax.nn.softmax((x @ w_router).astype(jnp.float32), axis=-1)
    gate, idx = lax.top_k(affinity.transpose(0, 2, 1), cap)
    xe = jax.vmap(lambda xb, ib: xb[ib])(x, idx)
    hidden = (jax.nn.silu(jnp.einsum('becd,edf->becf', xe, w1))
              * jnp.einsum('becd,edf->becf', xe, w3))
    ye = jnp.einsum('becf,efd->becd', hidden, w2) * gate[..., None].astype(x.dtype)
    return jax.vmap(
        lambda yb, ib: jnp.zeros((n, d), yb.dtype).at[ib.reshape(-1)].add(yb.reshape(-1, d))
    )(ye, idx)


def setup_inputs(seed: int = 0) -> dict:
    key = jax.random.key(seed)
    ks = jax.random.split(key, 24)

    def normal(k, shape, fan_in):
        return jax.random.normal(k, shape, jnp.float32) * (fan_in ** -0.5)

    def gain(k, shape):
        return 1.0 + 0.02 * jax.random.normal(k, shape, jnp.float32)

    return {
        "x": jax.random.normal(ks[0], (BATCH, SEQ, D_MODEL), jnp.float32),
        "norm_mix_w": gain(ks[1], (DEPTH, D_MODEL)),
        "w_in": normal(ks[2], (DEPTH, D_MODEL, D_IN_PROJ), D_MODEL),
        "gla_gate_up_f": normal(ks[3], (DEPTH, GLA_GATE_RANK, GLA_KEY), GLA_GATE_RANK),
        "gla_gate_bias_f": 0.1 * jax.random.normal(ks[4], (DEPTH, GLA_KEY), jnp.float32),
        "gla_gate_up_b": normal(ks[5], (DEPTH, GLA_GATE_RANK, GLA_KEY), GLA_GATE_RANK),
        "gla_gate_bias_b": 0.1 * jax.random.normal(ks[6], (DEPTH, GLA_KEY), jnp.float32),
        "gla_norm_w": gain(ks[7], (DEPTH, GLA_DV)),
        "hgrn_lb_logits_f": 0.5 * jax.random.normal(ks[8], (DEPTH + 1, D_HGRN), jnp.float32),
        "hgrn_lb_logits_b": 0.5 * jax.random.normal(ks[9], (DEPTH + 1, D_HGRN), jnp.float32),
        "hgrn_norm_w": gain(ks[10], (DEPTH, HGRN_EXPAND)),
        "w_out": normal(ks[11], (DEPTH, D_MIX, D_MODEL), D_MIX),
        "norm_ffn_w": gain(ks[12], (DEPTH, D_MODEL)),
        "w_router": normal(ks[13], (DEPTH, D_MODEL, N_EXPERTS), D_MODEL),
        "expert_w1": normal(ks[14], (DEPTH, N_EXPERTS, D_MODEL, D_EXPERT), D_MODEL),
        "expert_w3": normal(ks[15], (DEPTH, N_EXPERTS, D_MODEL, D_EXPERT), D_MODEL),
        "expert_w2": normal(ks[16], (DEPTH, N_EXPERTS, D_EXPERT, D_MODEL), D_EXPERT),
        "norm_final_w": gain(ks[17], (D_MODEL,)),
    }


def reference(x, norm_mix_w, w_in, gla_gate_up_f, gla_gate_bias_f, gla_gate_up_b,
              gla_gate_bias_b, gla_norm_w, hgrn_lb_logits_f, hgrn_lb_logits_b,
              hgrn_norm_w, w_out, norm_ffn_w, w_router, expert_w1, expert_w3,
              expert_w2, norm_final_w):
    split_points = [int(p) for p in np.cumsum(SPLIT_SIZES)[:-1]]
    lb_table_f = jnp.cumsum(jax.nn.softmax(hgrn_lb_logits_f.astype(jnp.float32), axis=0), axis=0)
    lb_table_b = jnp.cumsum(jax.nn.softmax(hgrn_lb_logits_b.astype(jnp.float32), axis=0), axis=0)
    for layer in range(DEPTH):
        xn = rms_norm(x, norm_mix_w[layer])
        proj = xn @ w_in[layer]
        (g_q, g_k, g_v, g_low_f, g_low_b, g_og,
         h_q, h_f_f, h_f_b, h_i, h_og) = jnp.split(proj, split_points, axis=-1)
        gla_out = gla_group(g_q, g_k, g_v, g_low_f, g_low_b, g_og,
                            gla_gate_up_f[layer], gla_gate_bias_f[layer],
                            gla_gate_up_b[layer], gla_gate_bias_b[layer],
                            gla_norm_w[layer])
        hgrn_out = hgrn2_group(h_q, h_f_f, h_f_b, h_i, h_og,
                               lb_table_f[layer], lb_table_b[layer], hgrn_norm_w[layer])
        mixed = jnp.concatenate([gla_out, hgrn_out], axis=-1)
        x = x + mixed @ w_out[layer]
        xn = rms_norm(x, norm_ffn_w[layer])
        x = x + expert_choice_ffn(xn, w_router[layer], expert_w1[layer],
                                  expert_w3[layer], expert_w2[layer])
    return rms_norm(x, norm_final_w)
```

```cpp
#include <hip/hip_runtime.h>
#include <cstdio>
#include <cstdint>
namespace pg8 {
#define PG8_LAS __attribute__((address_space(3)))
typedef unsigned short bf16_t;
typedef short bf16x8 __attribute__((ext_vector_type(8)));
typedef float f32x4 __attribute__((ext_vector_type(4)));
typedef unsigned u32x4 __attribute__((ext_vector_type(4)));
constexpr int BM = 256, BK = 64, HALF = 128, HTB = HALF * BK * 2  , STAGE_BYTES = 8 * HTB, NXCD = 8, WGM = 8;

__host__ __device__ __forceinline__ int lds_byte(int r, int c) { const int st = (r >> 4) * 2 + (c >> 5), rr = r & 15, cc = c & 31, ob = rr * 64 + cc * 2; return st * 1024 + (ob ^ (((ob >> 9) & 1) << 5)); }
__host__ __device__ __forceinline__ void stage_rc(int b, int& R, int& C) { const int st = b / 1024, sb = b % 1024, swz = sb ^ (((sb >> 9) & 1) << 5); R = (st >> 1) * 16 + swz / 64; C = (st & 1) * 32 + (swz % 64) / 2; }
__host__ __device__ __forceinline__ int perm32(int rho) { const int n = rho >> 4, i = rho & 15; return 8 * (i >> 2) + 4 * n + (i & 3); }

struct Unit { int pm, pn; };
struct Gemm { const bf16_t* A; const bf16_t* Bt; int M, N, K; };

struct StaticOrder {
    int nM, nN, nwg, G, c;
    __host__ __device__ void init(int M, int N, int G_, int c_) { nM = M / BM; nN = N / BM; nwg = nM * nN; G = G_; c = c_; }
    __host__ __device__ bool next(int i, Unit& u) const {
        const long L = (long)i * G + c; if (L >= nwg) return false;
        int wgid = (int)L; { const int q = nwg / NXCD, r = nwg % NXCD, xcd = wgid % NXCD, off = wgid / NXCD; wgid = (xcd < r ? xcd * (q + 1) : r * (q + 1) + (xcd - r) * q) + off; }
        const int nig = WGM * nN, gid = wgid / nig, fm = gid * WGM, gsz = (nM - fm) < WGM ? (nM - fm) : WGM;
        u.pm = fm + ((wgid % nig) % gsz); u.pn = (wgid % nig) / gsz; return true;
    }
    __device__ __forceinline__ void a_ready(const Unit&) const {}
    __device__ __forceinline__ void done(const Unit&) const {}
};
__device__ __forceinline__ unsigned cvt_pk_bf16(float lo, float hi) { unsigned r; asm volatile("v_cvt_pk_bf16_f32 %0, %1, %2" : "=v"(r) : "v"(lo), "v"(hi)); return r; }
typedef float f32x2 __attribute__((ext_vector_type(2)));
template <class Epi, class Sched, bool ALIGN_EPI = false, bool SP2 = false>
__device__ __forceinline__ void gemm_phase(PG8_LAS unsigned char* lds, const Gemm g, const Sched& S, const Epi& E) {
    const int tid = threadIdx.x, wid = __builtin_amdgcn_readfirstlane(tid >> 6), lane = tid & 63, wr = wid >> 2, wc = wid & 3, fr = lane & 15, fq = lane >> 4;
    const int K = g.K, nt = K / BK;
    unsigned voffA[2], voffB[2];
#pragma unroll
    for (int i = 0; i < 2; ++i) { int R, C; stage_rc(tid * 16 + i * 8192, R, C); const int Rb = Epi::PERM ? ((R & ~31) + perm32(R & 31)) : R;
        voffA[i] = (unsigned)(R * K + C) * 2u; voffB[i] = (unsigned)(Rb * K + C) * 2u; }
    const size_t kstep = (size_t)(BK * 2);
    const size_t hstep = (size_t)HALF * K * 2;
    const size_t tstep = 2 * hstep;
    const unsigned ldsw = (unsigned)wid * 1024u;
    const int aoff = lds_byte(wr * 64 + fr, fq * 8), boff = lds_byte(wc * 32 + fr, fq * 8);
#define PG8_SA(b, h) (((b) * 2 + (h)) * HTB)
#define PG8_SB(b, h) ((4 + (b) * 2 + (h)) * HTB)
#define PG8_STAGE(bufoff, gbase, voff) do { _Pragma("unroll") for (int _i = 0; _i < 2; ++_i) \
        __builtin_amdgcn_global_load_lds((const unsigned*)((const char*)(gbase) + (voff)[_i]), (PG8_LAS unsigned*)(lds + (bufoff) + ldsw + _i * 8192), 16, 0, 0); } while (0)
#define PG8_LDA(dst, b, h) do { _Pragma("unroll") for (int m = 0; m < 4; ++m) _Pragma("unroll") for (int k = 0; k < 2; ++k) dst[m][k] = *(const PG8_LAS bf16x8*)(lds + PG8_SA(b, h) + aoff + m * 2048 + k * 1024); } while (0)
#define PG8_LDB(dst, b, h) do { _Pragma("unroll") for (int n = 0; n < 2; ++n) _Pragma("unroll") for (int k = 0; k < 2; ++k) dst[n][k] = *(const PG8_LAS bf16x8*)(lds + PG8_SB(b, h) + boff + n * 2048 + k * 1024); } while (0)
#define PG8_MMA(ai, bj, At, Bt) do { __builtin_amdgcn_s_setprio(1); _Pragma("unroll") for (int m = 0; m < 4; ++m) _Pragma("unroll") for (int n = 0; n < 2; ++n) _Pragma("unroll") for (int k = 0; k < 2; ++k) \
        acc[ai][bj][m][n] = __builtin_amdgcn_mfma_f32_16x16x32_bf16(Bt[n][k], At[m][k], acc[ai][bj][m][n], 0, 0, 0); __builtin_amdgcn_s_setprio(0); } while (0)
#define PG8_WAIT_V(n) asm volatile("s_waitcnt vmcnt(" #n ")" ::: "memory")
#define PG8_WAIT_L(n) asm volatile("s_waitcnt lgkmcnt(" #n ")" ::: "memory")
#define PG8_BAR __builtin_amdgcn_s_barrier()
#define PG8_SCHED __builtin_amdgcn_sched_barrier(0)
    Unit cur, nxt; int ui = 0;
    if (!S.next(0, cur)) return;
    f32x4 acc[2][2][4][2];
#pragma unroll
    for (int a = 0; a < 2; ++a)
#pragma unroll
        for (int b = 0; b < 2; ++b)
#pragma unroll
            for (int m = 0; m < 4; ++m)
#pragma unroll
                for (int n = 0; n < 2; ++n) acc[a][b][m][n] = (f32x4){0.f, 0.f, 0.f, 0.f};
    bf16x8 At[4][2], B0[2][2], B1[2][2];
    const char* cA = (const char*)g.A + (size_t)cur.pm * tstep; const char* cB = (const char*)g.Bt + (size_t)cur.pn * tstep;
    S.a_ready(cur);
    if constexpr (SP2) {
        PG8_STAGE(PG8_SB(0, 0), cB, voffB); PG8_STAGE(PG8_SB(0, 1), cB + hstep, voffB); PG8_STAGE(PG8_SA(0, 0), cA, voffA); PG8_STAGE(PG8_SA(0, 1), cA + hstep, voffA);
        if (wr == 1) PG8_BAR;
        PG8_WAIT_V(2); PG8_BAR;
        PG8_STAGE(PG8_SB(1, 0), cB + kstep, voffB); PG8_STAGE(PG8_SA(1, 0), cA + kstep, voffA); PG8_STAGE(PG8_SB(1, 1), cB + hstep + kstep, voffB);
        PG8_WAIT_V(6); PG8_BAR;
    } else {
        PG8_STAGE(PG8_SB(0, 0), cB, voffB); PG8_STAGE(PG8_SA(0, 0), cA, voffA); PG8_STAGE(PG8_SB(0, 1), cB + hstep, voffB); PG8_STAGE(PG8_SA(0, 1), cA + hstep, voffA);
        if (wr == 1) PG8_BAR;
        PG8_WAIT_V(4); PG8_BAR;
        PG8_STAGE(PG8_SB(1, 0), cB + kstep, voffB); PG8_STAGE(PG8_SA(1, 0), cA + kstep, voffA); PG8_STAGE(PG8_SB(1, 1), cB + hstep + kstep, voffB);
        PG8_WAIT_V(6); PG8_BAR;
    }
    for (;;) {
        const bool has_next = S.next(ui + 1, nxt);
        const char* nA = has_next ? (const char*)g.A + (size_t)nxt.pm * tstep : cA; const char* nB = has_next ? (const char*)g.Bt + (size_t)nxt.pn * tstep : cB;
        for (int t = 0; t < nt; t += 2) {
            const bool last = (t == nt - 2);
            const char* a1 = cA + (size_t)(t + 1) * kstep;
            const char* a2 = last ? nA : cA + (size_t)(t + 2) * kstep; const char* b2 = last ? nB : cB + (size_t)(t + 2) * kstep;
            const char* a3 = a2 + kstep; const char* b3 = b2 + kstep;
            if (last && has_next) S.a_ready(nxt);
            if constexpr (SP2) {
            PG8_LDB(B0, 0, 0); PG8_LDB(B1, 0, 1); PG8_SCHED; PG8_LDA(At, 0, 0); PG8_STAGE(PG8_SA(1, 1), a1 + hstep, voffA);
            PG8_WAIT_V(8); PG8_WAIT_L(0); PG8_BAR; PG8_MMA(0, 0, At, B0); PG8_MMA(0, 1, At, B1); PG8_BAR; PG8_SCHED;
            PG8_LDA(At, 0, 1); PG8_STAGE(PG8_SB(0, 0), b2, voffB); PG8_STAGE(PG8_SB(0, 1), b2 + hstep, voffB); PG8_STAGE(PG8_SA(0, 0), a2, voffA);
            PG8_WAIT_V(8); PG8_WAIT_L(0); PG8_BAR; PG8_MMA(1, 0, At, B0); PG8_MMA(1, 1, At, B1); PG8_BAR; PG8_SCHED;
            PG8_LDB(B0, 1, 0); PG8_LDB(B1, 1, 1); PG8_SCHED; PG8_LDA(At, 1, 0); PG8_STAGE(PG8_SA(0, 1), a2 + hstep, voffA);
            PG8_WAIT_V(8); PG8_WAIT_L(0); PG8_BAR; PG8_MMA(0, 0, At, B0); PG8_MMA(0, 1, At, B1); PG8_BAR; PG8_SCHED;
            PG8_LDA(At, 1, 1); PG8_STAGE(PG8_SB(1, 0), b3, voffB); PG8_STAGE(PG8_SB(1, 1), b3 + hstep, voffB); PG8_STAGE(PG8_SA(1, 0), a3, voffA);
            PG8_WAIT_V(8); PG8_WAIT_L(0); PG8_BAR; PG8_MMA(1, 0, At, B0); PG8_MMA(1, 1, At, B1); PG8_BAR; PG8_SCHED;
            } else {
            PG8_LDB(B0, 0, 0); PG8_SCHED; PG8_LDA(At, 0, 0); PG8_STAGE(PG8_SA(1, 1), a1 + hstep, voffA);
            PG8_WAIT_L(8); PG8_BAR; PG8_WAIT_L(0); PG8_MMA(0, 0, At, B0); PG8_BAR; PG8_SCHED;
            PG8_LDB(B1, 0, 1); PG8_STAGE(PG8_SB(0, 0), b2, voffB);
            PG8_BAR; PG8_WAIT_L(0); PG8_MMA(0, 1, At, B1); PG8_BAR;
            PG8_LDA(At, 0, 1); PG8_STAGE(PG8_SA(0, 0), a2, voffA);
            PG8_BAR; PG8_WAIT_L(0); PG8_MMA(1, 0, At, B0); PG8_BAR; PG8_SCHED;
            PG8_STAGE(PG8_SB(0, 1), b2 + hstep, voffB);
            PG8_WAIT_V(6); PG8_BAR; PG8_MMA(1, 1, At, B1); PG8_BAR;
            PG8_LDB(B0, 1, 0); PG8_SCHED; PG8_LDA(At, 1, 0); PG8_STAGE(PG8_SA(0, 1), a2 + hstep, voffA);
            PG8_WAIT_L(8); PG8_BAR; PG8_WAIT_L(0); PG8_MMA(0, 0, At, B0); PG8_BAR; PG8_SCHED;
            PG8_LDB(B1, 1, 1); PG8_STAGE(PG8_SB(1, 0), b3, voffB);
            PG8_BAR; PG8_WAIT_L(0); PG8_MMA(0, 1, At, B1); PG8_BAR;
            PG8_LDA(At, 1, 1); PG8_STAGE(PG8_SA(1, 0), a3, voffA);
            PG8_BAR; PG8_WAIT_L(0); PG8_MMA(1, 0, At, B0); PG8_BAR; PG8_SCHED;
            PG8_STAGE(PG8_SB(1, 1), b3 + hstep, voffB);
            PG8_WAIT_V(6); PG8_BAR; PG8_MMA(1, 1, At, B1); PG8_BAR;
            }
        }
        if constexpr (ALIGN_EPI) { if (wr == 0) PG8_BAR; }
        if constexpr (!Epi::AFTER_DRAIN) { E(acc, cur, wr, wc, fr, fq); S.done(cur); }
        if (!has_next) break;
#pragma unroll
        for (int a = 0; a < 2; ++a)
#pragma unroll
            for (int b = 0; b < 2; ++b)
#pragma unroll
                for (int m = 0; m < 4; ++m)
#pragma unroll
                    for (int n = 0; n < 2; ++n) acc[a][b][m][n] = (f32x4){0.f, 0.f, 0.f, 0.f};
        cur = nxt; cA = nA; cB = nB; ++ui;
        if constexpr (ALIGN_EPI) { if (wr == 1) PG8_BAR; }
    }
    PG8_WAIT_V(0);
    if constexpr (!ALIGN_EPI) { if (wr == 0) PG8_BAR; }
    PG8_BAR;
    if constexpr (Epi::AFTER_DRAIN) { E.fused(acc, cur, wr, wc, fr, fq, lds, wid, lane); S.done(cur); }
#undef PG8_SA
#undef PG8_SB
#undef PG8_STAGE
#undef PG8_LDA
#undef PG8_LDB
#undef PG8_MMA
#undef PG8_WAIT_V
#undef PG8_WAIT_L
#undef PG8_BAR
#undef PG8_SCHED
}
}
#define GAS __attribute__((address_space(1)))
#define LAS __attribute__((address_space(3)))
typedef unsigned short bf16;
typedef unsigned v4u __attribute__((ext_vector_type(4)));
typedef float f32x4 __attribute__((ext_vector_type(4)));
typedef short bf16x8 __attribute__((ext_vector_type(8)));
typedef GAS unsigned gu32;
typedef GAS unsigned long long gu64;
#define RLX_AGENT __ATOMIC_RELAXED, __HIP_MEMORY_SCOPE_AGENT
#define LDS_WAIT() asm volatile("s_waitcnt lgkmcnt(0)" ::: "memory")
#define VM_WAIT() asm volatile("s_waitcnt vmcnt(0)" ::: "memory")
__device__ __forceinline__ unsigned long long rt() { return __builtin_amdgcn_s_memrealtime(); }
__device__ __forceinline__ unsigned f2bf(float f) { unsigned u = __builtin_bit_cast(unsigned, f); return (u + 0x7fffu + ((u >> 16) & 1u)) >> 16; }
__device__ __forceinline__ unsigned pk2(float lo, float hi) { return f2bf(lo) | (f2bf(hi) << 16); }
#define XB_TMO      128
#define XB_XCNT(j)  (256  + 64 * (j))
#define XB_XSUB(j)  (1280 + 64 * (j))
#define XB_XGEN(j)  (2304 + 64 * (j))
#define XB_TOP      3328
#define XB_TOPGEN   3392
#define XCD_BAR_WORDS 3456
#define XB_SPIN_CAP (1u << 18)

__device__ __forceinline__ unsigned xb_ld(unsigned* p)              { return __hip_atomic_load(p, __ATOMIC_RELAXED, __HIP_MEMORY_SCOPE_AGENT); }
__device__ __forceinline__ unsigned xb_add(unsigned* p, unsigned v) { return __hip_atomic_fetch_add(p, v, __ATOMIC_RELAXED, __HIP_MEMORY_SCOPE_AGENT); }
__device__ __forceinline__ unsigned xb_xcc_id() { return (unsigned)__builtin_amdgcn_s_getreg((3 << 11) | 20) & 0xFu; }
#define XB_SPIN(cond, bar) do { unsigned _sp = 0; while (cond) { __builtin_amdgcn_s_sleep(1); \
    if ((++_sp & 255u) == 0u) { if (xb_ld(&(bar)[XB_TMO])) break; if (_sp > XB_SPIN_CAP) { atomicAdd(&(bar)[XB_TMO], 1u); break; } } } } while (0)

struct XcdBarrier {
    unsigned* bar; unsigned x;
    volatile LAS unsigned* st;
};

__device__ __forceinline__ XcdBarrier xcd_barrier_post(unsigned* bar, volatile LAS unsigned* st) {
    XcdBarrier b; b.bar = bar; b.x = xb_xcc_id(); b.st = st;
    if (threadIdx.x == 0) (void)xb_add(&bar[XB_XCNT(b.x)], 1u);
    return b;
}
__device__ __forceinline__ void xcd_barrier_complete(unsigned* bar, unsigned x, unsigned& nloc, unsigned& nx) {
    const unsigned G = gridDim.x * gridDim.y * gridDim.z;
    unsigned sum, cnt, mine, sp = 0u;
    for (;;) {
        sum = 0u; cnt = 0u; mine = 0u;
#pragma unroll
        for (unsigned j = 0; j < 16; ++j) { const unsigned c = xb_ld(&bar[XB_XCNT(j)]); sum += c; cnt += (c > 0u) ? 1u : 0u; mine = (j == x) ? c : mine; }
        if (sum == G) break;
        __builtin_amdgcn_s_sleep(1);
        if ((++sp & 255u) == 0u) { if (xb_ld(&bar[XB_TMO])) break; if (sp > XB_SPIN_CAP) { atomicAdd(&bar[XB_TMO], 1u); break; } }
    }
    nloc = mine > 0u ? mine : 1u; nx = cnt > 0u ? cnt : 1u;
}

__device__ __forceinline__ void xcd_barrier(const XcdBarrier& b) {
    asm volatile("s_waitcnt vmcnt(0)" ::: "memory");
    __syncthreads();
    if (threadIdx.x == 0) {
        unsigned* bar = b.bar;
        __builtin_amdgcn_s_waitcnt(0);
        unsigned nloc = b.st[0], nx = b.st[1];
        if (nloc == 0u) { xcd_barrier_complete(bar, b.x, nloc, nx); b.st[0] = nloc; b.st[1] = nx; }
        const unsigned old = xb_add(&bar[XB_XSUB(b.x)], 1u);
        const unsigned gen = old / nloc;
        if (old + 1u == (gen + 1u) * nloc) {
            __builtin_amdgcn_fence(__ATOMIC_RELEASE, "agent");
            asm volatile("s_waitcnt vmcnt(0)" ::: "memory");
            const unsigned og = xb_add(&bar[XB_TOP], 1u);
            const unsigned tg = og / nx;
            if (og + 1u == (tg + 1u) * nx) xb_add(&bar[XB_TOPGEN], 1u);
            else XB_SPIN(xb_ld(&bar[XB_TOPGEN]) == tg, bar);
            __builtin_amdgcn_fence(__ATOMIC_ACQUIRE, "agent");
            xb_add(&bar[XB_XGEN(b.x)], 1u);
            asm volatile("s_waitcnt vmcnt(0)" ::: "memory");
        } else {
            XB_SPIN(xb_ld(&bar[XB_XGEN(b.x)]) == gen, bar);
            __builtin_amdgcn_fence(__ATOMIC_ACQUIRE, "agent");
            asm volatile("s_waitcnt vmcnt(0)" ::: "memory");
        }
    }
    __syncthreads();
}

constexpr int NWAVES = 8;
constexpr int TT = 8192, DM = 4096, NSRC = 16416, NPROJ = 16384;
constexpr int NEXP = 16, DEXP = 2048, CAP = 1024;
constexpr float EPS = 1e-6f;
constexpr int N_PHASES = 12;
#ifndef MK_ONE_LAUNCH
#define MK_ONE_LAUNCH 0
#endif

constexpr size_t MiB = 1u << 20;
constexpr size_t WS_CTL = 0, CTL_ZERO_BYTES = 1 * MiB;
constexpr size_t WS_WLOWT = 1 * MiB;
constexpr size_t WS_GLOW = 2 * MiB;
constexpr size_t WS_AFFT = 3 * MiB;
constexpr size_t WS_IDX = 3 * MiB + 512 * 1024;
constexpr size_t WS_GATEV = WS_IDX + 64 * 1024;
constexpr size_t WS_SLOT = 4 * MiB;
constexpr size_t WS_WINT = 8 * MiB;
constexpr size_t WS_WOUTT = 136 * MiB;
constexpr size_t WS_W13T = 168 * MiB;
constexpr size_t WS_W2T = 680 * MiB;
constexpr size_t WS_XN = 936 * MiB;
constexpr size_t WS_H = 1000 * MiB;
constexpr size_t WS_ACT = 1128 * MiB;
constexpr size_t WS_GQ = WS_ACT, WS_GK = WS_ACT + 16 * MiB, WS_GV = WS_ACT + 32 * MiB, WS_GOG = WS_ACT + 64 * MiB, WS_HQ = WS_ACT + 96 * MiB;
constexpr size_t WS_HFF = WS_ACT + 128 * MiB, WS_HFB = WS_ACT + 192 * MiB, WS_HI = WS_ACT + 256 * MiB, WS_HOG = WS_ACT + 288 * MiB;
constexpr size_t WS_GCF = WS_ACT + 320 * MiB, WS_GCB = WS_ACT + 352 * MiB, WS_HKF = WS_ACT + 384 * MiB, WS_HKB = WS_ACT + 416 * MiB;
constexpr size_t WS_OF = WS_ACT + 448 * MiB, WS_OB = WS_ACT + 512 * MiB;
constexpr size_t WS_XE = WS_ACT, WS_HID = WS_ACT + 128 * MiB, WS_YE = WS_ACT + 192 * MiB;
constexpr size_t WS_END = WS_ACT + 576 * MiB;
constexpr int CW_BAR = 4096;

constexpr int RING_BYTES = 131072, LDSCTL_OFF = RING_BYTES, MISC_OFF = LDSCTL_OFF + 320, LDS_BYTES = 147456;

typedef __bf16 bf2_t __attribute__((ext_vector_type(2)));
typedef float f2_t __attribute__((ext_vector_type(2)));
typedef unsigned v2u __attribute__((ext_vector_type(2)));
__device__ __forceinline__ unsigned pkbf(float lo, float hi) { f2_t v = {lo, hi}; return __builtin_bit_cast(unsigned, __builtin_convertvector(v, bf2_t)); }
__device__ __forceinline__ float bflo(unsigned w) { return __builtin_bit_cast(float, w << 16); }
__device__ __forceinline__ float bfhi(unsigned w) { return __builtin_bit_cast(float, w & 0xffff0000u); }
__device__ __forceinline__ float silu_f(float x) { return x / (1.0f + __expf(-x)); }
__device__ __forceinline__ float wave_sum(float v) {
#pragma unroll
    for (int o = 1; o < 64; o <<= 1) v += __shfl_xor(v, o);
    return v;
}
#define MFMA16(a, b, c) __builtin_amdgcn_mfma_f32_16x16x32_bf16((a), (b), (c), 0, 0, 0)

struct Args { const float* in[18]; float* out; unsigned char* ws; int ph_lo, ph_hi; };

namespace pg8 {
struct EpiInProj {
    static constexpr bool PERM = true, AFTER_DRAIN = false;
    unsigned char* ws;
    __device__ __forceinline__ void operator()(const f32x4 (&acc)[2][2][4][2], const Unit& u, int wr, int wc, int fr, int fq) const {
        const int pn = u.pn; int mode = 0, ld = 2048, pl = 0; float sc = 1.f; size_t off = 0;
        if (pn < 4) { off = WS_GQ; ld = 1024; pl = pn; sc = 0.08838834764831845f; }
        else if (pn < 8) { off = WS_GK; ld = 1024; pl = pn - 4; }
        else if (pn < 16) { off = WS_GV; pl = pn - 8; }
        else if (pn < 24) { off = WS_GOG; pl = pn - 16; mode = 1; }
        else if (pn < 32) { off = WS_HQ; pl = pn - 24; mode = 1; sc = 0.08838834764831845f; }
        else if (pn < 40) { off = WS_HFF; pl = pn - 32; mode = 2; }
        else if (pn < 48) { off = WS_HFB; pl = pn - 40; mode = 2; }
        else if (pn < 56) { off = WS_HI; pl = pn - 48; }
        else { off = WS_HOG; pl = pn - 56; mode = 1; }
        const int row0 = u.pm * BM + wr * 64 + fr, col0 = pl * BM + wc * 32 + 8 * fq;
        if (mode == 2) {
            float* base = (float*)(ws + off);
#pragma unroll
            for (int ai = 0; ai < 2; ++ai)
#pragma unroll
                for (int m = 0; m < 4; ++m) { float* rowp = base + (size_t)(row0 + ai * HALF + m * 16) * ld + col0;
#pragma unroll
                    for (int bj = 0; bj < 2; ++bj) { *(f32x4*)(rowp + bj * HALF) = acc[ai][bj][m][0]; *(f32x4*)(rowp + bj * HALF + 4) = acc[ai][bj][m][1]; } }
        } else {
            bf16_t* base = (bf16_t*)(ws + off);
#pragma unroll
            for (int ai = 0; ai < 2; ++ai)
#pragma unroll
                for (int m = 0; m < 4; ++m) { bf16_t* rowp = base + (size_t)(row0 + ai * HALF + m * 16) * ld + col0;
#pragma unroll
                    for (int bj = 0; bj < 2; ++bj) { f32x4 v0 = acc[ai][bj][m][0], v1 = acc[ai][bj][m][1];
                        if (mode == 1) {
#pragma unroll
                            for (int j = 0; j < 4; ++j) { v0[j] = silu_f(v0[j]); v1[j] = silu_f(v1[j]); } }
                        v0 = v0 * sc; v1 = v1 * sc;
                        u32x4 w; w.x = pkbf(v0[0], v0[1]); w.y = pkbf(v0[2], v0[3]); w.z = pkbf(v1[0], v1[1]); w.w = pkbf(v1[2], v1[3]);
                        *(u32x4*)(rowp + bj * HALF) = w; } }
        }
    }
};
struct EpiResF32 {
    static constexpr bool PERM = false, AFTER_DRAIN = false;
    const float* base; float* C; int ldc;
    __device__ __forceinline__ void operator()(const f32x4 (&acc)[2][2][4][2], const Unit& u, int wr, int wc, int fr, int fq) const {
        const int row0 = u.pm * BM + wr * 64 + fr, col0 = u.pn * BM + wc * 32 + 4 * fq;
#pragma unroll
        for (int ai = 0; ai < 2; ++ai)
#pragma unroll
            for (int m = 0; m < 4; ++m) { const size_t o = (size_t)(row0 + ai * HALF + m * 16) * ldc + col0;
#pragma unroll
                for (int bj = 0; bj < 2; ++bj)
#pragma unroll
                    for (int n = 0; n < 2; ++n) { const f32x4 b = *(const f32x4*)(base + o + bj * HALF + n * 16); *(f32x4*)(C + o + bj * HALF + n * 16) = acc[ai][bj][m][n] + b; } }
    }
};
struct EpiSwiglu {
    static constexpr bool PERM = true, AFTER_DRAIN = false;
    bf16_t* HID;
    __device__ __forceinline__ void operator()(const f32x4 (&acc)[2][2][4][2], const Unit& u, int wr, int wc, int fr, int fq) const {
        const int row0 = u.pm * BM + wr * 64 + fr, col0 = (u.pn & 15) * HALF + wc * 32 + 8 * fq;
#pragma unroll
        for (int ai = 0; ai < 2; ++ai)
#pragma unroll
            for (int m = 0; m < 4; ++m) { bf16_t* rowp = HID + (size_t)(row0 + ai * HALF + m * 16) * DEXP + col0;
                float o[8];
#pragma unroll
                for (int n = 0; n < 2; ++n)
#pragma unroll
                    for (int j = 0; j < 4; ++j) o[4 * n + j] = silu_f(acc[ai][0][m][n][j]) * acc[ai][1][m][n][j];
                u32x4 w; w.x = pkbf(o[0], o[1]); w.y = pkbf(o[2], o[3]); w.z = pkbf(o[4], o[5]); w.w = pkbf(o[6], o[7]);
                *(u32x4*)rowp = w; }
    }
};
struct EpiGate {
    static constexpr bool PERM = true, AFTER_DRAIN = false;
    bf16_t* YE; const float* gate;
    __device__ __forceinline__ void operator()(const f32x4 (&acc)[2][2][4][2], const Unit& u, int wr, int wc, int fr, int fq) const {
        const int row0 = u.pm * BM + wr * 64 + fr, col0 = (u.pn & 15) * BM + wc * 32 + 8 * fq;
#pragma unroll
        for (int ai = 0; ai < 2; ++ai)
#pragma unroll
            for (int m = 0; m < 4; ++m) { const int r = row0 + ai * HALF + m * 16; const float gt = gate[r]; bf16_t* rowp = YE + (size_t)r * DM + col0;
#pragma unroll
                for (int bj = 0; bj < 2; ++bj) { const f32x4 v0 = acc[ai][bj][m][0] * gt, v1 = acc[ai][bj][m][1] * gt;
                    u32x4 w; w.x = pkbf(v0[0], v0[1]); w.y = pkbf(v0[2], v0[3]); w.z = pkbf(v1[0], v1[1]); w.w = pkbf(v1[2], v1[3]);
                    *(u32x4*)(rowp + bj * HALF) = w; } }
    }
};
struct GroupedOrder {
    int c;
    __device__ __forceinline__ bool next(int i, Unit& u) const {
        if (i >= 4) return false;
        const int xcd = c & 7, j = c >> 3, e = 2 * xcd + (i >> 1);
        u.pm = 4 * e + (j & 3); u.pn = 16 * e + 8 * (i & 1) + (j >> 2); return true;
    }
    __device__ __forceinline__ void a_ready(const Unit&) const {}
    __device__ __forceinline__ void done(const Unit&) const {}
};
}

__device__ __forceinline__ void transpose_item(const float* src, size_t lds_, bf16* dst, size_t ldd, LAS float* scr, int lane) {
#pragma unroll 8
    for (int i = 0; i < 32; ++i) { const int kk = 2 * i + (lane >> 5); scr[kk * 33 + (lane & 31)] = src[(size_t)kk * lds_ + (lane & 31)]; }
    LDS_WAIT(); asm volatile("" ::: "memory");
    const int c = lane & 7;
#pragma unroll
    for (int j = 0; j < 4; ++j) { const int n = (lane >> 3) + 8 * j; const LAS float* s = scr + (8 * c) * 33 + n;
        v4u o; o.x = pkbf(s[0 * 33], s[1 * 33]); o.y = pkbf(s[2 * 33], s[3 * 33]); o.z = pkbf(s[4 * 33], s[5 * 33]); o.w = pkbf(s[6 * 33], s[7 * 33]);
        *(GAS v4u*)(dst + (size_t)n * ldd + 8 * c) = o; }
    LDS_WAIT(); asm volatile("" ::: "memory");
}
__device__ __forceinline__ void rms_row_to_bf16(const float* xrow, const float* w, bf16* orow, int lane) {
    const GAS f32x4* xr = (const GAS f32x4*)xrow + lane; const GAS f32x4* wr = (const GAS f32x4*)w + lane;
    f32x4 v[16]; float s = 0.f;
#pragma unroll
    for (int j = 0; j < 16; ++j) { v[j] = xr[64 * j]; s += (v[j].x * v[j].x + v[j].y * v[j].y) + (v[j].z * v[j].z + v[j].w * v[j].w); }
    const float rstd = 1.0f / sqrtf(wave_sum(s) * (1.f / DM) + EPS);
    GAS v2u* o8 = (GAS v2u*)orow + lane;
#pragma unroll
    for (int j = 0; j < 16; ++j) { const f32x4 ww = wr[64 * j]; v2u o; o.x = pkbf(v[j].x * rstd * ww.x, v[j].y * rstd * ww.y); o.y = pkbf(v[j].z * rstd * ww.z, v[j].w * rstd * ww.w); o8[64 * j] = o; }
}
__device__ __forceinline__ void p0_prologue(const Args& a, LAS unsigned char* lds, int lane, int wave, int vcu, int G) {
    LAS float* scr = (LAS float*)(lds + wave * 16384);
    const int gw = vcu * NWAVES + wave, NGW = G * NWAVES;
    const float* w_in = a.in[2]; const float* w_out = a.in[11]; const float* w1 = a.in[14]; const float* w3 = a.in[15]; const float* w2 = a.in[16];
    bf16* WINT = (bf16*)(a.ws + WS_WINT); bf16* WLOWT = (bf16*)(a.ws + WS_WLOWT); bf16* WOUTT = (bf16*)(a.ws + WS_WOUTT); bf16* W13T = (bf16*)(a.ws + WS_W13T); bf16* W2T = (bf16*)(a.ws + WS_W2T);
    constexpr int I_A = 64 * 512, I_B = 64, I_C = 64 * 128, I_D = 16 * 4096, I_E = I_D, I_F = 16 * 4096;
    constexpr int NITEMS = I_A + I_B + I_C + I_D + I_E + I_F;
    for (int it = gw; it < NITEMS; it += NGW) {
        int r = it;
        if (r < I_A) { const int kb = r >> 9, nb = r & 511, n0 = 32 * nb, sc = n0 < 4096 ? n0 : n0 + 32;
            transpose_item(w_in + (size_t)(64 * kb) * NSRC + sc, NSRC, WINT + (size_t)n0 * DM + 64 * kb, DM, scr, lane); continue; } r -= I_A;
        if (r < I_B) { transpose_item(w_in + (size_t)(64 * r) * NSRC + 4096, NSRC, WLOWT + 64 * r, DM, scr, lane); continue; } r -= I_B;
        if (r < I_C) { const int kb = r >> 7, nb = r & 127;
            transpose_item(w_out + (size_t)(64 * kb) * DM + 32 * nb, DM, WOUTT + (size_t)(32 * nb) * DM + 64 * kb, DM, scr, lane); continue; } r -= I_C;
        if (r < I_D + I_E) { const int is3 = r >= I_D; if (is3) r -= I_D; const int e = r >> 12, q = r & 4095, kb = q >> 6, nb = q & 63, n0 = 32 * nb, drow = (n0 >> 7) * 256 + (n0 & 127) + (is3 ? 128 : 0);
            transpose_item((is3 ? w3 : w1) + (size_t)e * DM * DEXP + (size_t)(64 * kb) * DEXP + n0, DEXP, W13T + ((size_t)e * 4096 + drow) * DM + 64 * kb, DM, scr, lane); continue; } r -= I_D + I_E;
        { const int e = r >> 12, q = r & 4095, kb = q >> 7, nb = q & 127, n0 = 32 * nb;
            transpose_item(w2 + (size_t)e * DEXP * DM + (size_t)(64 * kb) * DM + n0, DM, W2T + ((size_t)e * 4096 + n0) * DEXP + 64 * kb, DEXP, scr, lane); }
    }
    const float* x = a.in[0]; const float* nw = a.in[1]; bf16* XN = (bf16*)(a.ws + WS_XN);
    for (int m = gw; m < TT; m += NGW) rms_row_to_bf16(x + (size_t)m * DM, nw, XN + (size_t)m * DM, lane);
}

typedef float f32x16 __attribute__((ext_vector_type(16)));
__device__ __forceinline__ void p1_glow(const Args& a, LAS unsigned char* lds, int tid, int lane, int wave) {
    const bf16* XN = (const bf16*)(a.ws + WS_XN); const bf16* WL = (const bf16*)(a.ws + WS_WLOWT); float* GLOW = (float*)(a.ws + WS_GLOW);
    LAS float* scr = (LAS float*)lds;
    for (int blk = blockIdx.x; blk < TT / 32; blk += gridDim.x) {
        const int r = lane & 31, h = lane >> 5;
        const bf16* ap = XN + (size_t)(32 * blk + r) * DM + 512 * wave + 8 * h; const bf16* bp = WL + (size_t)r * DM + 512 * wave + 8 * h;
        f32x16 acc; for (int i = 0; i < 16; ++i) acc[i] = 0.f;
#pragma unroll 4
        for (int s = 0; s < 32; ++s) { const bf16x8 av = *(const GAS bf16x8*)(ap + 16 * s), bv = *(const GAS bf16x8*)(bp + 16 * s);
            acc = __builtin_amdgcn_mfma_f32_32x32x16_bf16(av, bv, acc, 0, 0, 0); }
#pragma unroll
        for (int i = 0; i < 16; ++i) { const int row = (i & 3) + 8 * (i >> 2) + 4 * h; scr[(wave * 32 + row) * 33 + r] = acc[i]; }
        __syncthreads();
#pragma unroll
        for (int q = 0; q < 2; ++q) { const int o = tid + 512 * q, row = o >> 5, col = o & 31; float s = 0.f;
#pragma unroll
            for (int w = 0; w < 8; ++w) s += scr[(w * 32 + row) * 33 + col];
            GLOW[(size_t)(32 * blk + row) * 32 + col] = s; }
        __syncthreads();
    }
}

__device__ __forceinline__ void p2_gates(const Args& a, int tid) {
    const float* GLOW = (const float*)(a.ws + WS_GLOW);
    for (int u = blockIdx.x; u < 1536; u += gridDim.x) {
        if (u < 512) {
            const int c = u >> 2, dir = (u >> 1) & 1, n = (u & 1) * 512 + tid;
            const float* up = dir ? a.in[5] : a.in[3]; const float* bias = dir ? a.in[6] : a.in[4];
            float upr[16];
#pragma unroll
            for (int j = 0; j < 16; ++j) upr[j] = up[j * 1024 + n];
            const float b = bias[n]; float* dst = (float*)(a.ws + (dir ? WS_GCB : WS_GCF)); float run = 0.f;
            for (int rr = 0; rr < 64; ++rr) { const int r = dir ? 63 - rr : rr, t = 64 * c + r; const float* gl = GLOW + (size_t)t * 32 + 16 * dir;
                float z = b;
#pragma unroll
                for (int j = 0; j < 16; ++j) z = fmaf(gl[j], upr[j], z);
                const float la = (fminf(z, 0.f) - log1pf(expf(-fabsf(z)))) * 0.0625f;
                run += la; dst[(size_t)t * 1024 + n] = run; }
        } else {
            const int uu = u - 512, c = uu >> 3, dir = (uu >> 2) & 1, n = (uu & 3) * 512 + tid;
            const float* lg = dir ? a.in[9] : a.in[8];
            const float lb = 1.0f / (1.0f + expf(lg[2048 + n] - lg[n]));
            float* fc = (float*)(a.ws + (dir ? WS_HFB : WS_HFF)); bf16* kk = (bf16*)(a.ws + (dir ? WS_HKB : WS_HKF)); float run = 0.f;
            for (int rr = 0; rr < 64; ++rr) { const int r = dir ? 63 - rr : rr, t = 64 * c + r; const size_t o = (size_t)t * 2048 + n;
                const float fr = fc[o]; const float s = 1.0f / (1.0f + expf(-fr)), sn = 1.0f / (1.0f + expf(fr));
                const float f = lb + (1.0f - lb) * s; run += logf(f); fc[o] = run; kk[o] = (bf16)(pkbf((1.0f - lb) * sn, 0.f) & 0xffffu); }
        }
    }
}

constexpr int SQ_STR = 272, SV_STR = 144;
constexpr int L_QM = 0, L_KM = 17408, L_V = 34816, L_P = 44032, L_F = 53248, L_OX = 53760;
__device__ __forceinline__ void p3_scan(const Args& a, LAS unsigned char* lds, int tid, int lane, int wave) {
    const int job = blockIdx.x;
    if (job < 128) {
        const bf16 *qp, *kp, *vp; const float* cp; bf16* op; int ldq, ldc, dir;
        if (job < 64) { const int seq = job >> 2, head = seq >> 1, sl = job & 3; dir = seq & 1;
            qp = (const bf16*)(a.ws + WS_GQ) + head * 128; kp = (const bf16*)(a.ws + WS_GK) + head * 128; ldq = 1024;
            cp = (const float*)(a.ws + (dir ? WS_GCB : WS_GCF)) + head * 128; ldc = 1024;
            vp = (const bf16*)(a.ws + WS_GV) + head * 256 + sl * 64; op = (bf16*)(a.ws + (dir ? WS_OB : WS_OF)) + head * 256 + sl * 64; }
        else { const int jj = job - 64, seq = jj >> 1, head = seq >> 1, sl = jj & 1; dir = seq & 1;
            qp = (const bf16*)(a.ws + WS_HQ) + head * 128; kp = (const bf16*)(a.ws + (dir ? WS_HKB : WS_HKF)) + head * 128; ldq = 2048;
            cp = (const float*)(a.ws + (dir ? WS_HFB : WS_HFF)) + head * 128; ldc = 2048;
            vp = (const bf16*)(a.ws + WS_HI) + head * 128 + sl * 64; op = (bf16*)(a.ws + (dir ? WS_OB : WS_OF)) + 2048 + head * 128 + sl * 64; }
        const int oct = tid & 15, s0 = tid >> 4;
        const int vs = tid >> 3, vo = tid & 7;
        const int lastrow = dir ? 0 : 63;
        v4u rq[2], rk[2], rv; f32x4 rc[2][2], rm[2]; float rlast = 0.f, rmid = 0.f;
#define P3_LOAD(ci) do { const size_t t0_ = (size_t)(ci) * 64; \
            _Pragma("unroll") for (int i_ = 0; i_ < 2; ++i_) { const size_t row_ = t0_ + s0 + 32 * i_; \
                rq[i_] = *(const GAS v4u*)(qp + row_ * ldq + 8 * oct); rk[i_] = *(const GAS v4u*)(kp + row_ * ldq + 8 * oct); \
                rc[i_][0] = *(const GAS f32x4*)(cp + row_ * ldc + 8 * oct); rc[i_][1] = *(const GAS f32x4*)(cp + row_ * ldc + 8 * oct + 4); } \
            rm[0] = *(const GAS f32x4*)(cp + (t0_ + 32) * ldc + 8 * oct); rm[1] = *(const GAS f32x4*)(cp + (t0_ + 32) * ldc + 8 * oct + 4); \
            rv = *(const GAS v4u*)(vp + (t0_ + vs) * 2048 + 8 * vo); \
            if (tid < 128) { rlast = cp[(t0_ + lastrow) * ldc + tid]; rmid = cp[(t0_ + 32) * ldc + tid]; } } while (0)
        P3_LOAD(dir ? 127 : 0);
        float carry = 0.f;
        const int g = lane >> 4, c16 = lane & 15, cs = wave & 3, dh = wave >> 2;
        f32x4 S[4];
#pragma unroll
        for (int n = 0; n < 4; ++n) S[n] = (f32x4){0.f, 0.f, 0.f, 0.f};
        for (int step = 0; step < 128; ++step) {
            const int ci = dir ? 127 - step : step; const size_t t0 = (size_t)ci * 64;
            __syncthreads();
#pragma unroll
            for (int i = 0; i < 2; ++i) {
                float qm[8], km[8];
#pragma unroll
                for (int j = 0; j < 8; ++j) { const unsigned qw = rq[i][j >> 1], kw = rk[i][j >> 1]; const float qv = (j & 1) ? bfhi(qw) : bflo(qw), kv = (j & 1) ? bfhi(kw) : bflo(kw);
                    const float d = rc[i][j >> 2][j & 3] - rm[j >> 2][j & 3]; qm[j] = qv * __expf(d); km[j] = kv * __expf(-d); }
                v4u wq, wk; wq.x = pkbf(qm[0], qm[1]); wq.y = pkbf(qm[2], qm[3]); wq.z = pkbf(qm[4], qm[5]); wq.w = pkbf(qm[6], qm[7]);
                wk.x = pkbf(km[0], km[1]); wk.y = pkbf(km[2], km[3]); wk.z = pkbf(km[4], km[5]); wk.w = pkbf(km[6], km[7]);
                *(LAS v4u*)(lds + L_QM + (s0 + 32 * i) * SQ_STR + 16 * oct) = wq; *(LAS v4u*)(lds + L_KM + (s0 + 32 * i) * SQ_STR + 16 * oct) = wk; }
            *(LAS v4u*)(lds + L_V + vs * SV_STR + 16 * vo) = rv;
            if (tid < 128) { ((LAS float*)(lds + L_F))[tid] = __expf(rmid + carry); carry = rlast - rmid; }
            if (step + 1 < 128) P3_LOAD(dir ? 126 - step : step + 1);
            __syncthreads();
#pragma unroll
            for (int n = 0; n < 4; ++n) { const f32x4 f = *(const LAS f32x4*)(lds + L_F + (64 * dh + 16 * n + 4 * g) * 4); S[n] = S[n] * f; }
            { const int st = wave >> 1, tt0 = 2 * (wave & 1);
              f32x4 X0 = {0.f, 0.f, 0.f, 0.f}, X1 = {0.f, 0.f, 0.f, 0.f};
#pragma unroll
              for (int ks = 0; ks < 4; ++ks) { const bf16x8 A = *(const LAS bf16x8*)(lds + L_KM + (16 * st + c16) * SQ_STR + (32 * ks + 8 * g) * 2);
                  const bf16x8 B0 = *(const LAS bf16x8*)(lds + L_QM + (16 * tt0 + c16) * SQ_STR + (32 * ks + 8 * g) * 2), B1 = *(const LAS bf16x8*)(lds + L_QM + (16 * tt0 + 16 + c16) * SQ_STR + (32 * ks + 8 * g) * 2);
                  X0 = MFMA16(A, B0, X0); X1 = MFMA16(A, B1, X1); }
              const int sb = 16 * st + 4 * g, ta = 16 * tt0 + c16, tb = ta + 16;
#pragma unroll
              for (int i = 0; i < 4; ++i) { const int s = sb + i; const bool ka = dir ? (s >= ta) : (s <= ta), kb = dir ? (s >= tb) : (s <= tb); X0[i] = ka ? X0[i] : 0.f; X1[i] = kb ? X1[i] : 0.f; }
              v2u w0, w1; w0.x = pkbf(X0[0], X0[1]); w0.y = pkbf(X0[2], X0[3]); w1.x = pkbf(X1[0], X1[1]); w1.y = pkbf(X1[2], X1[3]);
              *(LAS v2u*)(lds + L_P + ta * SV_STR + sb * 2) = w0; *(LAS v2u*)(lds + L_P + tb * SV_STR + sb * 2) = w1; }
            __syncthreads();
            bf16x8 vb[2];
#pragma unroll
            for (int ks = 0; ks < 2; ++ks)
#pragma unroll
                for (int j = 0; j < 8; ++j) vb[ks][j] = *(const LAS short*)(lds + L_V + (32 * ks + 8 * g + j) * SV_STR + (16 * cs + c16) * 2);
            f32x4 O[4];
#pragma unroll
            for (int m = 0; m < 4; ++m) O[m] = (f32x4){0.f, 0.f, 0.f, 0.f};
#pragma unroll
            for (int m = 0; m < 4; ++m) { const bf16x8 A = *(const LAS bf16x8*)(lds + L_P + (16 * m + c16) * SV_STR + (32 * dh + 8 * g) * 2); O[m] = MFMA16(A, dh ? vb[1] : vb[0], O[m]); }
#pragma unroll
            for (int p = 0; p < 2; ++p) { v4u bw; bw.x = pkbf(S[2 * p][0], S[2 * p][1]); bw.y = pkbf(S[2 * p][2], S[2 * p][3]); bw.z = pkbf(S[2 * p + 1][0], S[2 * p + 1][1]); bw.w = pkbf(S[2 * p + 1][2], S[2 * p + 1][3]);
                const bf16x8 B = __builtin_bit_cast(bf16x8, bw);
#pragma unroll
                for (int m = 0; m < 4; ++m) { const LAS unsigned char* qa = lds + L_QM + (16 * m + c16) * SQ_STR + (64 * dh + 32 * p + 4 * g) * 2;
                    const v2u lo = *(const LAS v2u*)qa, hi = *(const LAS v2u*)(qa + 32); v4u aw; aw.x = lo.x; aw.y = lo.y; aw.z = hi.x; aw.w = hi.y;
                    O[m] = MFMA16(__builtin_bit_cast(bf16x8, aw), B, O[m]); } }
#pragma unroll
            for (int n = 0; n < 4; ++n)
#pragma unroll
                for (int ks = 0; ks < 2; ++ks) { bf16x8 A;
#pragma unroll
                    for (int j = 0; j < 8; ++j) A[j] = *(const LAS short*)(lds + L_KM + (32 * ks + 8 * g + j) * SQ_STR + (64 * dh + 16 * n + c16) * 2);
                    S[n] = MFMA16(A, vb[ks], S[n]); }
            if (dh == 1) {
#pragma unroll
                for (int m = 0; m < 4; ++m)
#pragma unroll
                    for (int i = 0; i < 4; ++i) ((LAS float*)(lds + L_OX))[(16 * m + 4 * g + i) * 68 + 16 * cs + c16] = O[m][i]; }
            __syncthreads();
            if (dh == 0) {
#pragma unroll
                for (int m = 0; m < 4; ++m)
#pragma unroll
                    for (int i = 0; i < 4; ++i) { const int t = 16 * m + 4 * g + i; const float v = O[m][i] + ((const LAS float*)(lds + L_OX))[t * 68 + 16 * cs + c16];
                        op[(t0 + t) * 4096 + 16 * cs + c16] = (bf16)(pkbf(v, 0.f) & 0xffffu); } }
        }
#undef P3_LOAD
    }
}

__device__ __forceinline__ void p4_combine(const Args& a, int lane, int wave, int vcu, int G) {
    const int gw = vcu * NWAVES + wave, NGW = G * NWAVES;
    const bf16* OF = (const bf16*)(a.ws + WS_OF); const bf16* OB = (const bf16*)(a.ws + WS_OB);
    const bf16* GOG = (const bf16*)(a.ws + WS_GOG); const bf16* HOG = (const bf16*)(a.ws + WS_HOG); bf16* MX = (bf16*)(a.ws + WS_XN);
    const float* gw_ = a.in[7]; const float* hw_ = a.in[10];
    float wg[8], wh[8];
#pragma unroll
    for (int j = 0; j < 8; ++j) { wg[j] = gw_[8 * (lane & 31) + j]; wh[j] = hw_[8 * (lane & 15) + j]; }
    for (int row = gw; row < TT; row += NGW) {
#pragma unroll
        for (int c = 0; c < 8; ++c) {
            const size_t o = (size_t)row * DM + 512 * c + 8 * lane;
            const v4u vf = *(const GAS v4u*)(OF + o), vb = *(const GAS v4u*)(OB + o);
            const v4u og = (c < 4) ? *(const GAS v4u*)(GOG + (size_t)row * 2048 + 512 * c + 8 * lane) : *(const GAS v4u*)(HOG + (size_t)row * 2048 + 512 * (c - 4) + 8 * lane);
            float v[8]; float ss = 0.f;
#pragma unroll
            for (int j = 0; j < 4; ++j) { v[2 * j] = bflo(vf[j]) + bflo(vb[j]); v[2 * j + 1] = bfhi(vf[j]) + bfhi(vb[j]); ss += v[2 * j] * v[2 * j] + v[2 * j + 1] * v[2 * j + 1]; }
            ss += __shfl_xor(ss, 1); ss += __shfl_xor(ss, 2); ss += __shfl_xor(ss, 4); ss += __shfl_xor(ss, 8);
            float rs;
            if (c < 4) { ss += __shfl_xor(ss, 16); rs = 1.0f / sqrtf(ss * (1.f / 256.f) + EPS); } else rs = 1.0f / sqrtf(ss * (1.f / 128.f) + EPS);
            v4u w;
#pragma unroll
            for (int j = 0; j < 4; ++j) { const float w0 = (c < 4) ? wg[2 * j] : wh[2 * j], w1 = (c < 4) ? wg[2 * j + 1] : wh[2 * j + 1];
                w[j] = pkbf(v[2 * j] * rs * w0 * bflo(og[j]), v[2 * j + 1] * rs * w1 * bfhi(og[j])); }
            *(GAS v4u*)(MX + o) = w;
        }
    }
}

__device__ __forceinline__ void p6_router(const Args& a, int lane, int wave, int vcu, int G) {
    const int gw = vcu * NWAVES + wave, NGW = G * NWAVES;
    const float* H = (const float*)(a.ws + WS_H); const float* nw = a.in[12]; const float* wr = a.in[13];
    bf16* XN2 = (bf16*)(a.ws + WS_XN); float* AFFT = (float*)(a.ws + WS_AFFT);
    for (int r0 = 4 * gw; r0 < TT; r0 += 4 * NGW) {
        float acc[4][16]; float ss[4];
#pragma unroll
        for (int r = 0; r < 4; ++r) { ss[r] = 0.f;
#pragma unroll
            for (int e = 0; e < 16; ++e) acc[r][e] = 0.f; }
        for (int j = 0; j < 16; ++j) {
            const int k = 256 * j + 4 * lane; const f32x4 wn = *(const GAS f32x4*)(nw + k);
            f32x4 hw[4];
#pragma unroll
            for (int r = 0; r < 4; ++r) { const f32x4 h = *(const GAS f32x4*)(H + (size_t)(r0 + r) * DM + k); ss[r] += (h.x * h.x + h.y * h.y) + (h.z * h.z + h.w * h.w); hw[r] = h * wn; }
#pragma unroll
            for (int kk = 0; kk < 4; ++kk) {
                f32x4 w4[4];
#pragma unroll
                for (int q = 0; q < 4; ++q) w4[q] = *(const GAS f32x4*)(wr + (size_t)(k + kk) * 16 + 4 * q);
#pragma unroll
                for (int r = 0; r < 4; ++r)
#pragma unroll
                    for (int e = 0; e < 16; ++e) acc[r][e] = fmaf(hw[r][kk], w4[e >> 2][e & 3], acc[r][e]);
            }
        }
        float rstd[4];
#pragma unroll
        for (int r = 0; r < 4; ++r) { rstd[r] = 1.0f / sqrtf(wave_sum(ss[r]) * (1.f / DM) + EPS);
            float mx = -3.0e38f;
#pragma unroll
            for (int e = 0; e < 16; ++e) { acc[r][e] = wave_sum(acc[r][e]) * rstd[r]; mx = fmaxf(mx, acc[r][e]); }
            float den = 0.f;
#pragma unroll
            for (int e = 0; e < 16; ++e) { acc[r][e] = expf(acc[r][e] - mx); den += acc[r][e]; }
            const float inv = 1.0f / den; float mine = 0.f;
#pragma unroll
            for (int e = 0; e < 16; ++e) mine = (lane == e) ? acc[r][e] * inv : mine;
            if (lane < 16) AFFT[(size_t)lane * TT + r0 + r] = mine; }
        for (int j = 0; j < 16; ++j) {
            const int k = 256 * j + 4 * lane; const f32x4 wn = *(const GAS f32x4*)(nw + k);
#pragma unroll
            for (int r = 0; r < 4; ++r) { const f32x4 h = *(const GAS f32x4*)(H + (size_t)(r0 + r) * DM + k); v2u o; o.x = pkbf(h.x * rstd[r] * wn.x, h.y * rstd[r] * wn.y); o.y = pkbf(h.z * rstd[r] * wn.z, h.w * rstd[r] * wn.w);
                *(GAS v2u*)(XN2 + (size_t)(r0 + r) * DM + k) = o; }
        }
    }
}

__device__ __forceinline__ void p7_topk(const Args& a, LAS unsigned char* lds, int tid, int lane, int wave) {
    if (blockIdx.x < NEXP) {
        const int e = blockIdx.x; const float* AFFT = (const float*)(a.ws + WS_AFFT) + (size_t)e * TT;
        int* IDX = (int*)(a.ws + WS_IDX) + e * CAP; float* GATEV = (float*)(a.ws + WS_GATEV) + e * CAP; int* SLOT = (int*)(a.ws + WS_SLOT);
        volatile LAS int* cnt = (volatile LAS int*)lds;
        unsigned u[16];
#pragma unroll
        for (int j = 0; j < 16; ++j) u[j] = __builtin_bit_cast(unsigned, AFFT[tid + 512 * j]);
        unsigned thr = 0u;
        for (int bit = 30; bit >= 0; --bit) {
            const unsigned cand = thr | (1u << bit); int c = 0;
#pragma unroll
            for (int j = 0; j < 16; ++j) c += __popcll(__ballot(u[j] >= cand));
            if (lane == 0) cnt[(bit & 1) * 8 + wave] = c;
            __syncthreads();
            int tot = 0;
#pragma unroll
            for (int w = 0; w < 8; ++w) tot += cnt[(bit & 1) * 8 + w];
            if (tot >= CAP) thr = cand;
        }
        __syncthreads();
        { int c = 0;
#pragma unroll
          for (int j = 0; j < 16; ++j) c += __popcll(__ballot(u[j] > thr));
          if (lane == 0) cnt[wave] = c; }
        __syncthreads();
        int n_gt = 0;
#pragma unroll
        for (int w = 0; w < 8; ++w) n_gt += cnt[w];
        const int need_eq = CAP - n_gt;
        __syncthreads();
        int base_gt = 0, base_eq = 0; const unsigned long long lt = (1ull << lane) - 1ull;
        for (int j = 0; j < 16; ++j) {
            const bool gt = u[j] > thr, eq = u[j] == thr;
            const unsigned long long bg = __ballot(gt), be = __ballot(eq);
            volatile LAS int* pb = cnt + 16 + (j & 1) * 16;
            if (lane == 0) { pb[wave] = __popcll(bg); pb[8 + wave] = __popcll(be); }
            __syncthreads();
            int wg_ = 0, we = 0, tg = 0, te = 0;
#pragma unroll
            for (int w = 0; w < 8; ++w) { const int cg = pb[w], ce = pb[8 + w]; if (w < wave) { wg_ += cg; we += ce; } tg += cg; te += ce; }
            const int gt_before = base_gt + wg_ + __popcll(bg & lt), eq_before = base_eq + we + __popcll(be & lt);
            const bool sel = gt || (eq && eq_before < need_eq);
            const int pos = gt_before + (eq_before < need_eq ? eq_before : need_eq);
            const int t = tid + 512 * j;
            if (sel) { IDX[pos] = t; GATEV[pos] = __builtin_bit_cast(float, u[j]); }
            SLOT[(size_t)t * 16 + e] = sel ? pos : -1;
            base_gt += tg; base_eq += te;
        }
    }
}

__device__ __forceinline__ void p8_gather(const Args& a, int lane, int wave, int vcu, int G) {
    const int gw = vcu * NWAVES + wave, NGW = G * NWAVES;
    const bf16* XN2 = (const bf16*)(a.ws + WS_XN); bf16* XE = (bf16*)(a.ws + WS_XE); const int* IDX = (const int*)(a.ws + WS_IDX);
    for (int r = gw; r < NEXP * CAP; r += NGW) { const int t = IDX[r]; const GAS v4u* s = (const GAS v4u*)(XN2 + (size_t)t * DM) + lane; GAS v4u* d = (GAS v4u*)(XE + (size_t)r * DM) + lane;
#pragma unroll
        for (int j = 0; j < 8; ++j) d[64 * j] = s[64 * j]; }
}

__device__ __forceinline__ void p11_final(const Args& a, int lane, int wave, int vcu, int G) {
    const int gw = vcu * NWAVES + wave, NGW = G * NWAVES;
    const float* H = (const float*)(a.ws + WS_H); const bf16* YE = (const bf16*)(a.ws + WS_YE); const int* SLOT = (const int*)(a.ws + WS_SLOT); const float* nw = a.in[17];
    for (int row = gw; row < TT; row += NGW) {
        f32x4 v[16];
#pragma unroll
        for (int j = 0; j < 16; ++j) v[j] = *(const GAS f32x4*)(H + (size_t)row * DM + 256 * j + 4 * lane);
        for (int e = 0; e < NEXP; ++e) { const int sl = __builtin_amdgcn_readfirstlane(SLOT[(size_t)row * 16 + e]);
            if (sl >= 0) { const bf16* y = YE + ((size_t)e * CAP + sl) * DM;
#pragma unroll
                for (int j = 0; j < 16; ++j) { const v2u w = *(const GAS v2u*)(y + 256 * j + 4 * lane); v[j].x += bflo(w.x); v[j].y += bfhi(w.x); v[j].z += bflo(w.y); v[j].w += bfhi(w.y); } } }
        float s = 0.f;
#pragma unroll
        for (int j = 0; j < 16; ++j) s += (v[j].x * v[j].x + v[j].y * v[j].y) + (v[j].z * v[j].z + v[j].w * v[j].w);
        const float rstd = 1.0f / sqrtf(wave_sum(s) * (1.f / DM) + EPS);
#pragma unroll
        for (int j = 0; j < 16; ++j) { const f32x4 ww = *(const GAS f32x4*)(nw + 256 * j + 4 * lane); *(GAS f32x4*)(a.out + (size_t)row * DM + 256 * j + 4 * lane) = v[j] * rstd * ww; }
    }
}

__global__ void __launch_bounds__(NWAVES * 64, 2) mk_fwd(Args args) {
    extern __shared__ __attribute__((aligned(16))) unsigned char lds_raw[];
    LAS unsigned char* lds = (LAS unsigned char*)lds_raw;
    const int tid = threadIdx.x, lane = tid & 63, wave = __builtin_amdgcn_readfirstlane(tid >> 6);
    const int G = gridDim.x; const int bx = blockIdx.x; const int vcu = (G % 8 == 0) ? (bx % 8) * (G / 8) + bx / 8 : bx;
    for (int u = tid; u < (LDS_BYTES - LDSCTL_OFF) / 4; u += NWAVES * 64) ((LAS unsigned*)(lds + LDSCTL_OFF))[u] = 0u;
    __syncthreads();
    XcdBarrier bar = xcd_barrier_post((unsigned*)(args.ws + WS_CTL) + CW_BAR, (volatile LAS unsigned*)(lds + MISC_OFF) + 8);
    const int lo = args.ph_lo, hi = args.ph_hi;
#define IN(k) (lo <= (k) && (k) < hi)
#define SEAM(k) do { if (IN(k) && IN((k) + 1)) xcd_barrier(bar); } while (0)
    if (IN(0)) { p0_prologue(args, lds, lane, wave, vcu, G); } SEAM(0);
    if (IN(1)) {
        p1_glow(args, lds, tid, lane, wave);
        pg8::Gemm g{(const pg8::bf16_t*)(args.ws + WS_XN), (const pg8::bf16_t*)(args.ws + WS_WINT), TT, NPROJ, DM}; pg8::StaticOrder S; S.init(TT, NPROJ, G, bx);
        pg8::EpiInProj E{args.ws};
        pg8::gemm_phase<pg8::EpiInProj, pg8::StaticOrder, true, true>(lds, g, S, E);
    } SEAM(1);
    if (IN(2)) { p2_gates(args, tid); } SEAM(2);
    if (IN(3)) { p3_scan(args, lds, tid, lane, wave); } SEAM(3);
    if (IN(4)) { p4_combine(args, lane, wave, vcu, G); } SEAM(4);
    if (IN(5)) {
        pg8::Gemm g{(const pg8::bf16_t*)(args.ws + WS_XN), (const pg8::bf16_t*)(args.ws + WS_WOUTT), TT, DM, DM}; pg8::StaticOrder S; S.init(TT, DM, G, bx);
        pg8::EpiResF32 E{args.in[0], (float*)(args.ws + WS_H), DM};
        pg8::gemm_phase<pg8::EpiResF32, pg8::StaticOrder, true, true>(lds, g, S, E);
    } SEAM(5);
    if (IN(6)) { p6_router(args, lane, wave, vcu, G); } SEAM(6);
    if (IN(7)) { p7_topk(args, lds, tid, lane, wave); } SEAM(7);
    if (IN(8)) { p8_gather(args, lane, wave, vcu, G); } SEAM(8);
    if (IN(9)) {
        pg8::Gemm g{(const pg8::bf16_t*)(args.ws + WS_XE), (const pg8::bf16_t*)(args.ws + WS_W13T), NEXP * CAP, 4096, DM}; pg8::GroupedOrder S{bx};
        pg8::EpiSwiglu E{(pg8::bf16_t*)(args.ws + WS_HID)};
        pg8::gemm_phase<pg8::EpiSwiglu, pg8::GroupedOrder, true, true>(lds, g, S, E);
    } SEAM(9);
    if (IN(10)) {
        pg8::Gemm g{(const pg8::bf16_t*)(args.ws + WS_HID), (const pg8::bf16_t*)(args.ws + WS_W2T), NEXP * CAP, 4096, DEXP}; pg8::GroupedOrder S{bx};
        pg8::EpiGate E{(pg8::bf16_t*)(args.ws + WS_YE), (const float*)(args.ws + WS_GATEV)};
        pg8::gemm_phase<pg8::EpiGate, pg8::GroupedOrder, true, true>(lds, g, S, E);
    } SEAM(10);
    if (IN(11)) { p11_final(args, lane, wave, vcu, G); }
#undef IN
#undef SEAM
}

extern "C" void kernel_launch(void* const* d_in, const int* in_sizes, int n_in, void* d_out, int out_size, void* d_ws, size_t ws_size, hipStream_t stream) {
    static int grid = 0;
    if (grid == 0) {
        if (n_in != 18 || out_size != TT * DM || ws_size < WS_END) { fprintf(stderr, "kernel_launch: unexpected shapes (n_in %d, out %d, ws %zu < %zu)\n", n_in, out_size, ws_size, (size_t)WS_END); grid = -1; return; }
        int dev = 0, cus = 0, per_cu = 0;
        if (hipGetDevice(&dev) != hipSuccess || hipDeviceGetAttribute(&cus, hipDeviceAttributeMultiprocessorCount, dev) != hipSuccess) { grid = -1; return; }
        if (hipFuncSetAttribute((const void*)mk_fwd, hipFuncAttributeMaxDynamicSharedMemorySize, LDS_BYTES) != hipSuccess) { fprintf(stderr, "kernel_launch: hipFuncSetAttribute failed\n"); grid = -1; return; }
        if (hipOccupancyMaxActiveBlocksPerMultiprocessor(&per_cu, (const void*)mk_fwd, NWAVES * 64, LDS_BYTES) != hipSuccess || per_cu < 1) fprintf(stderr, "kernel_launch: occupancy query reports %d\n", per_cu);
        (void)hipGetLastError();
        grid = cus;
        if (grid != 256) fprintf(stderr, "kernel_launch: %d CUs (built for 256)\n", grid);
    }
    if (grid < 0) return;
    (void)hipMemsetAsync((char*)d_ws + WS_CTL, 0, CTL_ZERO_BYTES, stream);
    Args a{};
    for (int i = 0; i < 18; ++i) a.in[i] = (const float*)d_in[i];
    a.out = (float*)d_out; a.ws = (unsigned char*)d_ws;
#if MK_ONE_LAUNCH
    a.ph_lo = 0; a.ph_hi = N_PHASES;
    hipLaunchKernelGGL(mk_fwd, dim3(grid), dim3(NWAVES * 64), LDS_BYTES, stream, a);
#else
    for (int p = 0; p < N_PHASES; ++p) { a.ph_lo = p; a.ph_hi = p + 1; hipLaunchKernelGGL(mk_fwd, dim3(grid), dim3(NWAVES * 64), LDS_BYTES, stream, a); }
#endif
}
```

```cpp
#include <hip/hip_runtime.h>
#include <cstdio>
#include <cstdint>
namespace pg8 {
#define PG8_LAS __attribute__((address_space(3)))
typedef unsigned short bf16_t;
typedef short bf16x8 __attribute__((ext_vector_type(8)));
typedef float f32x4 __attribute__((ext_vector_type(4)));
typedef unsigned u32x4 __attribute__((ext_vector_type(4)));
typedef long i64x2 __attribute__((ext_vector_type(2)));
typedef int i32x4 __attribute__((ext_vector_type(4)));
typedef int i32x8 __attribute__((ext_vector_type(8)));
constexpr int BM = 256, BK = 64, HALF = 128, HTB = HALF * BK * 2  , STAGE_BYTES = 8 * HTB, NXCD = 8, WGM = 8;

__host__ __device__ __forceinline__ int lds_byte(int r, int c) { const int st = (r >> 4) * 2 + (c >> 5), rr = r & 15, cc = c & 31, ob = rr * 64 + cc * 2; return st * 1024 + (ob ^ (((ob >> 9) & 1) << 5)); }
__host__ __device__ __forceinline__ void stage_rc(int b, int& R, int& C) { const int st = b / 1024, sb = b % 1024, swz = sb ^ (((sb >> 9) & 1) << 5); R = (st >> 1) * 16 + swz / 64; C = (st & 1) * 32 + (swz % 64) / 2; }
__host__ __device__ __forceinline__ int perm32(int rho) { const int n = rho >> 4, i = rho & 15; return 8 * (i >> 2) + 4 * n + (i & 3); }

struct Unit { int pm, pn; };
struct Gemm { const bf16_t* A; const bf16_t* Bt; int M, N, K; const int* gidx = nullptr; };

struct StaticOrder {
    int nM, nN, nwg, G, c;
    __host__ __device__ void init(int M, int N, int G_, int c_) { nM = M / BM; nN = N / BM; nwg = nM * nN; G = G_; c = c_; }
    __host__ __device__ bool next(int i, Unit& u) const {
        const long L = (long)i * G + c; if (L >= nwg) return false;
        int wgid = (int)L; { const int q = nwg / NXCD, r = nwg % NXCD, xcd = wgid % NXCD, off = wgid / NXCD; wgid = (xcd < r ? xcd * (q + 1) : r * (q + 1) + (xcd - r) * q) + off; }
        const int nig = WGM * nN, gid = wgid / nig, fm = gid * WGM, gsz = (nM - fm) < WGM ? (nM - fm) : WGM;
        u.pm = fm + ((wgid % nig) % gsz); u.pn = (wgid % nig) / gsz; return true;
    }
    __device__ __forceinline__ void a_ready(const Unit&) const {}
    __device__ __forceinline__ void done(const Unit&) const {}
};
__device__ __forceinline__ unsigned cvt_pk_bf16(float lo, float hi) { unsigned r; asm volatile("v_cvt_pk_bf16_f32 %0, %1, %2" : "=v"(r) : "v"(lo), "v"(hi)); return r; }
typedef float f32x2 __attribute__((ext_vector_type(2)));
template <class Epi, class Sched, bool ALIGN_EPI = false, bool SP2 = false, bool GATHER = false, bool FP8 = false>
__device__ __forceinline__ void gemm_phase(PG8_LAS unsigned char* lds, const Gemm g, const Sched& S, const Epi& E, const int wid) {
    int lane; asm volatile("v_mbcnt_lo_u32_b32 %0, -1, 0\n\tv_mbcnt_hi_u32_b32 %0, -1, %0" : "=v"(lane)); const int tid = wid * 64 + lane, wr = wid >> 2, wc = wid & 3, fr = lane & 15, fq = lane >> 4;
    constexpr int ES = FP8 ? 1 : 2;
    const int K = g.K, nt = K * ES / (BK * 2);
    unsigned voffA[2], voffB[2];
#pragma unroll
    for (int i = 0; i < 2; ++i) { int R, C; stage_rc(tid * 16 + i * 8192, R, C); const int Rb = Epi::PERM ? ((R & ~31) + perm32(R & 31)) : R;
        voffA[i] = (unsigned)(R * K * ES + C * 2); voffB[i] = (unsigned)(Rb * K * ES + C * 2); }
    const __amdgpu_buffer_rsrc_t rsA = __builtin_amdgcn_make_buffer_rsrc((void*)g.A, 0, -1, 0x00020000), rsB = __builtin_amdgcn_make_buffer_rsrc((void*)g.Bt, 0, -1, 0x00020000);
    const size_t kstep = (size_t)(BK * 2);
    const size_t hstep = (size_t)HALF * K * ES;
    const size_t tstep = 2 * hstep;
    const unsigned ldsw = (unsigned)wid * 1024u;
    const int aoff = lds_byte(wr * 64 + fr, fq * 8), boff = lds_byte(wc * 32 + fr, fq * 8);
#define PG8_SA(b, h) (((b) * 2 + (h)) * HTB)
#define PG8_SB(b, h) ((4 + (b) * 2 + (h)) * HTB)
#define PG8_STAGE(bufoff, gbase, voff, RS, BASE0) do { _Pragma("unroll") for (int _i = 0; _i < 2; ++_i) { \
        if constexpr (FP8) __builtin_amdgcn_raw_ptr_buffer_load_lds(RS, (PG8_LAS void*)(lds + (bufoff) + ldsw + _i * 8192), 16, (int)(voff)[_i], (int)(unsigned)((const char*)(gbase) - (BASE0)), 0, 0); \
        else __builtin_amdgcn_global_load_lds((const unsigned*)((const char*)(gbase) + (voff)[_i]), (PG8_LAS unsigned*)(lds + (bufoff) + ldsw + _i * 8192), 16, 0, 0); } } while (0)
#define PG8_GPK(h, usenext) do { if constexpr (GATHER) { int l_; asm volatile("v_mbcnt_lo_u32_b32 %0, -1, 0\n\tv_mbcnt_hi_u32_b32 %0, -1, %0" : "=v"(l_)); \
        gpk = *(const PG8_LAS unsigned*)(lds + GTAB + ((usenext) ? nbank : bank) * 4096 + (h) * 2048 + wid * 256 + l_ * 4); } } while (0)
#define PG8_STAGE_A(bufoff, h, base_noh, usenext) do { if constexpr (GATHER) { const unsigned cc_ = voffB[0] & 127u; \
        __builtin_amdgcn_raw_ptr_buffer_load_lds(rsA, (PG8_LAS void*)(lds + (bufoff) + ldsw), 16, (int)((gpk & 0xffffu) * (unsigned)(K * ES) + cc_), (int)(unsigned)((const char*)(base_noh) - (const char*)g.A), 0, 0); \
        __builtin_amdgcn_raw_ptr_buffer_load_lds(rsA, (PG8_LAS void*)(lds + (bufoff) + ldsw + 8192), 16, (int)((gpk >> 16) * (unsigned)(K * ES) + cc_), (int)(unsigned)((const char*)(base_noh) - (const char*)g.A), 0, 0); } \
        else { PG8_STAGE(bufoff, (const char*)(base_noh) + (h) * hstep, voffA, rsA, (const char*)g.A); } } while (0)
#define PG8_GTAB_LOAD(bk, pm_) do { int l_; asm volatile("v_mbcnt_lo_u32_b32 %0, -1, 0\n\tv_mbcnt_hi_u32_b32 %0, -1, %0" : "=v"(l_)); _Pragma("unroll") for (int h_ = 0; h_ < 2; ++h_) \
        __builtin_amdgcn_raw_ptr_buffer_load_lds(rsG, (PG8_LAS void*)(lds + GTAB + (bk) * 4096 + h_ * 2048 + wid * 256), 4, (int)(l_ & 0x3c), (int)(((pm_) * 2 + h_) * 256 + (wid >> 1) * 64), 0, 0); } while (0)
#define PG8_LDA(dst, b, h) do { _Pragma("unroll") for (int m = 0; m < 4; ++m) { const bf16x8 l0_ = *(const PG8_LAS bf16x8*)(lds + PG8_SA(b, h) + aoff + m * 2048), l1_ = *(const PG8_LAS bf16x8*)(lds + PG8_SA(b, h) + aoff + m * 2048 + 1024); \
        if constexpr (FP8) dst##8[m] = __builtin_shufflevector(__builtin_bit_cast(i32x4, l0_), __builtin_bit_cast(i32x4, l1_), 0, 1, 2, 3, 4, 5, 6, 7); else { dst[m][0] = l0_; dst[m][1] = l1_; } } } while (0)
#define PG8_LDB(dst, b, h) do { _Pragma("unroll") for (int n = 0; n < 2; ++n) { const bf16x8 l0_ = *(const PG8_LAS bf16x8*)(lds + PG8_SB(b, h) + boff + n * 2048), l1_ = *(const PG8_LAS bf16x8*)(lds + PG8_SB(b, h) + boff + n * 2048 + 1024); \
        if constexpr (FP8) dst##8[n] = __builtin_shufflevector(__builtin_bit_cast(i32x4, l0_), __builtin_bit_cast(i32x4, l1_), 0, 1, 2, 3, 4, 5, 6, 7); else { dst[n][0] = l0_; dst[n][1] = l1_; } } } while (0)
#define PG8_MMA(ai, bj, At, Bt) do { __builtin_amdgcn_s_setprio(1); \
        if constexpr (FP8) { _Pragma("unroll") for (int m = 0; m < 4; ++m) _Pragma("unroll") for (int n = 0; n < 2; ++n) \
            acc[ai][bj][m][n] = __builtin_amdgcn_mfma_scale_f32_16x16x128_f8f6f4(Bt##8[n], At##8[m], acc[ai][bj][m][n], 0, 0, 0, 0x7f7f7f7f, 0, 0x7f7f7f7f); } \
        else { _Pragma("unroll") for (int m = 0; m < 4; ++m) _Pragma("unroll") for (int n = 0; n < 2; ++n) _Pragma("unroll") for (int k = 0; k < 2; ++k) \
            acc[ai][bj][m][n] = __builtin_amdgcn_mfma_f32_16x16x32_bf16(Bt[n][k], At[m][k], acc[ai][bj][m][n], 0, 0, 0); } __builtin_amdgcn_s_setprio(0); } while (0)
#define PG8_WAIT_V(n) asm volatile("s_waitcnt vmcnt(" #n ")" ::: "memory")
#define PG8_WAIT_L(n) asm volatile("s_waitcnt lgkmcnt(" #n ")" ::: "memory")
#define PG8_BAR __builtin_amdgcn_s_barrier()
#define PG8_SCHED __builtin_amdgcn_sched_barrier(0)
    Unit cur, nxt; int ui = 0;
    if (!S.next(0, cur)) return;
    f32x4 acc[2][2][4][2];
#pragma unroll
    for (int a = 0; a < 2; ++a)
#pragma unroll
        for (int b = 0; b < 2; ++b)
#pragma unroll
            for (int m = 0; m < 4; ++m)
#pragma unroll
                for (int n = 0; n < 2; ++n) acc[a][b][m][n] = (f32x4){0.f, 0.f, 0.f, 0.f};
    bf16x8 At[4][2], B0[2][2], B1[2][2]; i32x8 At8[4], B08[2], B18[2];
    const char* cA = GATHER ? (const char*)g.A : (const char*)g.A + (size_t)cur.pm * tstep; const char* cB = (const char*)g.Bt + (size_t)cur.pn * tstep;
    static_assert(!GATHER || FP8, "GATHER: e4m3 operands only");
    constexpr int GTAB = 8 * HTB;
    const __amdgpu_buffer_rsrc_t rsG = __builtin_amdgcn_make_buffer_rsrc((void*)(GATHER ? (const void*)g.gidx : (const void*)g.A), 0, -1, 0x00020000);
    int bank = 0, nbank = 0; unsigned gpk = 0u; (void)bank; (void)nbank; (void)gpk; (void)rsG;
    if constexpr (GATHER) { PG8_GTAB_LOAD(0, cur.pm); PG8_WAIT_V(0); }
    S.a_ready(cur);
    if constexpr (SP2) {
        PG8_STAGE(PG8_SB(0, 0), cB, voffB, rsB, (const char*)g.Bt); PG8_STAGE(PG8_SB(0, 1), cB + hstep, voffB, rsB, (const char*)g.Bt); PG8_GPK(0, false); PG8_STAGE_A(PG8_SA(0, 0), 0, cA, false); PG8_GPK(1, false); PG8_STAGE_A(PG8_SA(0, 1), 1, cA, false);
        if (wr == 1) PG8_BAR;
        PG8_WAIT_V(2); PG8_BAR;
        PG8_STAGE(PG8_SB(1, 0), cB + kstep, voffB, rsB, (const char*)g.Bt); PG8_GPK(0, false); PG8_STAGE_A(PG8_SA(1, 0), 0, cA + kstep, false); PG8_STAGE(PG8_SB(1, 1), cB + hstep + kstep, voffB, rsB, (const char*)g.Bt);
        PG8_WAIT_V(6); PG8_BAR;
        PG8_GPK(1, false);
    } else {
        PG8_STAGE(PG8_SB(0, 0), cB, voffB, rsB, (const char*)g.Bt); PG8_STAGE_A(PG8_SA(0, 0), 0, cA, false); PG8_STAGE(PG8_SB(0, 1), cB + hstep, voffB, rsB, (const char*)g.Bt); PG8_STAGE_A(PG8_SA(0, 1), 1, cA, false);
        if (wr == 1) PG8_BAR;
        PG8_WAIT_V(4); PG8_BAR;
        PG8_STAGE(PG8_SB(1, 0), cB + kstep, voffB, rsB, (const char*)g.Bt); PG8_STAGE_A(PG8_SA(1, 0), 0, cA + kstep, false); PG8_STAGE(PG8_SB(1, 1), cB + hstep + kstep, voffB, rsB, (const char*)g.Bt);
        PG8_WAIT_V(6); PG8_BAR;
    }
    for (;;) {
        const bool has_next = S.next(ui + 1, nxt);
        const char* nA = (has_next && !GATHER) ? (const char*)g.A + (size_t)nxt.pm * tstep : cA;
        if constexpr (GATHER) { nbank = has_next ? bank ^ 1 : bank; if (has_next) PG8_GTAB_LOAD(bank ^ 1, nxt.pm); }
        const char* nB = has_next ? (const char*)g.Bt + (size_t)nxt.pn * tstep : cB;
        for (int t = 0; t < nt; t += 2) {
            const bool last = (t == nt - 2);
            const char* a1 = cA + (size_t)(t + 1) * kstep;
            const char* a2 = last ? nA : cA + (size_t)(t + 2) * kstep; const char* b2 = last ? nB : cB + (size_t)(t + 2) * kstep;
            const char* a3 = a2 + kstep; const char* b3 = b2 + kstep;
            if (last && has_next) S.a_ready(nxt);
            if constexpr (SP2) {
            PG8_LDB(B0, 0, 0); PG8_LDB(B1, 0, 1); PG8_SCHED; PG8_LDA(At, 0, 0); PG8_STAGE_A(PG8_SA(1, 1), 1, a1, false); PG8_GPK(0, last);
            PG8_WAIT_V(8); PG8_WAIT_L(0); PG8_BAR; PG8_MMA(0, 0, At, B0); PG8_MMA(0, 1, At, B1); PG8_BAR; PG8_SCHED;
            PG8_LDA(At, 0, 1); PG8_STAGE(PG8_SB(0, 0), b2, voffB, rsB, (const char*)g.Bt); PG8_STAGE(PG8_SB(0, 1), b2 + hstep, voffB, rsB, (const char*)g.Bt); PG8_STAGE_A(PG8_SA(0, 0), 0, a2, last); PG8_GPK(1, last);
            PG8_WAIT_V(8); PG8_WAIT_L(0); PG8_BAR; PG8_MMA(1, 0, At, B0); PG8_MMA(1, 1, At, B1); PG8_BAR; PG8_SCHED;
            PG8_LDB(B0, 1, 0); PG8_LDB(B1, 1, 1); PG8_SCHED; PG8_LDA(At, 1, 0); PG8_STAGE_A(PG8_SA(0, 1), 1, a2, last); PG8_GPK(0, last);
            PG8_WAIT_V(8); PG8_WAIT_L(0); PG8_BAR; PG8_MMA(0, 0, At, B0); PG8_MMA(0, 1, At, B1); PG8_BAR; PG8_SCHED;
            PG8_LDA(At, 1, 1); PG8_STAGE(PG8_SB(1, 0), b3, voffB, rsB, (const char*)g.Bt); PG8_STAGE(PG8_SB(1, 1), b3 + hstep, voffB, rsB, (const char*)g.Bt); PG8_STAGE_A(PG8_SA(1, 0), 0, a3, last); PG8_GPK(1, last);
            PG8_WAIT_V(8); PG8_WAIT_L(0); PG8_BAR; PG8_MMA(1, 0, At, B0); PG8_MMA(1, 1, At, B1); PG8_BAR; PG8_SCHED;
            } else {
            PG8_LDB(B0, 0, 0); PG8_SCHED; PG8_LDA(At, 0, 0); PG8_STAGE_A(PG8_SA(1, 1), 1, a1, false);
            PG8_WAIT_L(8); PG8_BAR; PG8_WAIT_L(0); PG8_MMA(0, 0, At, B0); PG8_BAR; PG8_SCHED;
            PG8_LDB(B1, 0, 1); PG8_STAGE(PG8_SB(0, 0), b2, voffB, rsB, (const char*)g.Bt);
            PG8_BAR; PG8_WAIT_L(0); PG8_MMA(0, 1, At, B1); PG8_BAR;
            PG8_LDA(At, 0, 1); PG8_STAGE_A(PG8_SA(0, 0), 0, a2, last);
            PG8_BAR; PG8_WAIT_L(0); PG8_MMA(1, 0, At, B0); PG8_BAR; PG8_SCHED;
            PG8_STAGE(PG8_SB(0, 1), b2 + hstep, voffB, rsB, (const char*)g.Bt);
            PG8_WAIT_V(6); PG8_BAR; PG8_MMA(1, 1, At, B1); PG8_BAR;
            PG8_LDB(B0, 1, 0); PG8_SCHED; PG8_LDA(At, 1, 0); PG8_STAGE_A(PG8_SA(0, 1), 1, a2, last);
            PG8_WAIT_L(8); PG8_BAR; PG8_WAIT_L(0); PG8_MMA(0, 0, At, B0); PG8_BAR; PG8_SCHED;
            PG8_LDB(B1, 1, 1); PG8_STAGE(PG8_SB(1, 0), b3, voffB, rsB, (const char*)g.Bt);
            PG8_BAR; PG8_WAIT_L(0); PG8_MMA(0, 1, At, B1); PG8_BAR;
            PG8_LDA(At, 1, 1); PG8_STAGE_A(PG8_SA(1, 0), 0, a3, last);
            PG8_BAR; PG8_WAIT_L(0); PG8_MMA(1, 0, At, B0); PG8_BAR; PG8_SCHED;
            PG8_STAGE(PG8_SB(1, 1), b3 + hstep, voffB, rsB, (const char*)g.Bt);
            PG8_WAIT_V(6); PG8_BAR; PG8_MMA(1, 1, At, B1); PG8_BAR;
            }
        }
        if constexpr (ALIGN_EPI) { if (wr == 0) PG8_BAR; }
        if constexpr (!Epi::AFTER_DRAIN) { E(acc, cur, wr, wc, fr, fq); S.done(cur); }
        if (!has_next) break;
#pragma unroll
        for (int a = 0; a < 2; ++a)
#pragma unroll
            for (int b = 0; b < 2; ++b)
#pragma unroll
                for (int m = 0; m < 4; ++m)
#pragma unroll
                    for (int n = 0; n < 2; ++n) acc[a][b][m][n] = (f32x4){0.f, 0.f, 0.f, 0.f};
        cur = nxt; cA = nA; cB = nB; ++ui;
        if constexpr (GATHER) bank ^= 1;
        if constexpr (ALIGN_EPI) { if (wr == 1) PG8_BAR; }
    }
    PG8_WAIT_V(0);
    if constexpr (!ALIGN_EPI) { if (wr == 0) PG8_BAR; }
    PG8_BAR;
    if constexpr (Epi::AFTER_DRAIN) { E.fused(acc, cur, wr, wc, fr, fq, lds, wid, lane); S.done(cur); }
#undef PG8_SA
#undef PG8_SB
#undef PG8_STAGE
#undef PG8_STAGE_A
#undef PG8_GPK
#undef PG8_GTAB_LOAD
#undef PG8_LDA
#undef PG8_LDB
#undef PG8_MMA
#undef PG8_WAIT_V
#undef PG8_WAIT_L
#undef PG8_BAR
#undef PG8_SCHED
}
}
#define GAS __attribute__((address_space(1)))
#define LAS __attribute__((address_space(3)))
typedef unsigned short bf16;
typedef unsigned v4u __attribute__((ext_vector_type(4)));
typedef float f32x4 __attribute__((ext_vector_type(4)));
typedef short bf16x8 __attribute__((ext_vector_type(8)));
typedef GAS unsigned gu32;
typedef GAS unsigned long long gu64;
#define RLX_AGENT __ATOMIC_RELAXED, __HIP_MEMORY_SCOPE_AGENT
#define LDS_WAIT() asm volatile("s_waitcnt lgkmcnt(0)" ::: "memory")
#define VM_WAIT() asm volatile("s_waitcnt vmcnt(0)" ::: "memory")
__device__ __forceinline__ unsigned long long rt() { return __builtin_amdgcn_s_memrealtime(); }
__device__ __forceinline__ unsigned f2bf(float f) { unsigned u = __builtin_bit_cast(unsigned, f); return (u + 0x7fffu + ((u >> 16) & 1u)) >> 16; }
__device__ __forceinline__ unsigned pk2(float lo, float hi) { return f2bf(lo) | (f2bf(hi) << 16); }
#define XB_TMO      128
#define XB_XCNT(j)  (256  + 64 * (j))
#define XB_XSUB(j)  (1280 + 64 * (j))
#define XB_XGEN(j)  (2304 + 64 * (j))
#define XB_TOP      3328
#define XB_TOPGEN   3392
#define XCD_BAR_WORDS 3456
#define XB_SPIN_CAP (1u << 18)

__device__ __forceinline__ unsigned xb_ld(unsigned* p)              { return __hip_atomic_load(p, __ATOMIC_RELAXED, __HIP_MEMORY_SCOPE_AGENT); }
__device__ __forceinline__ unsigned xb_add(unsigned* p, unsigned v) { return __hip_atomic_fetch_add(p, v, __ATOMIC_RELAXED, __HIP_MEMORY_SCOPE_AGENT); }
__device__ __forceinline__ unsigned xb_xcc_id() { return (unsigned)__builtin_amdgcn_s_getreg((3 << 11) | 20) & 0xFu; }
#define XB_SPIN(cond, bar) do { unsigned _sp = 0; while (cond) { __builtin_amdgcn_s_sleep(1); \
    if ((++_sp & 255u) == 0u) { if (xb_ld(&(bar)[XB_TMO])) break; if (_sp > XB_SPIN_CAP) { atomicAdd(&(bar)[XB_TMO], 1u); break; } } } } while (0)

struct XcdBarrier {
    unsigned* bar; unsigned x;
    volatile LAS unsigned* st;
};

__device__ __forceinline__ XcdBarrier xcd_barrier_post(unsigned* bar, volatile LAS unsigned* st) {
    XcdBarrier b; b.bar = bar; b.x = xb_xcc_id(); b.st = st;
    if (threadIdx.x == 0) (void)xb_add(&bar[XB_XCNT(b.x)], 1u);
    return b;
}
__device__ __forceinline__ void xcd_barrier_complete(unsigned* bar, unsigned x, unsigned& nloc, unsigned& nx) {
    const unsigned G = gridDim.x * gridDim.y * gridDim.z;
    unsigned sum, cnt, mine, sp = 0u;
    for (;;) {
        sum = 0u; cnt = 0u; mine = 0u;
#pragma unroll
        for (unsigned j = 0; j < 16; ++j) { const unsigned c = xb_ld(&bar[XB_XCNT(j)]); sum += c; cnt += (c > 0u) ? 1u : 0u; mine = (j == x) ? c : mine; }
        if (sum == G) break;
        __builtin_amdgcn_s_sleep(1);
        if ((++sp & 255u) == 0u) { if (xb_ld(&bar[XB_TMO])) break; if (sp > XB_SPIN_CAP) { atomicAdd(&bar[XB_TMO], 1u); break; } }
    }
    nloc = mine > 0u ? mine : 1u; nx = cnt > 0u ? cnt : 1u;
}

__device__ __forceinline__ void xcd_barrier(const XcdBarrier& b) {
    asm volatile("s_waitcnt vmcnt(0)" ::: "memory");
    __syncthreads();
    if (threadIdx.x == 0) {
        unsigned* bar = b.bar;
        __builtin_amdgcn_s_waitcnt(0);
        unsigned nloc = b.st[0], nx = b.st[1];
        if (nloc == 0u) { xcd_barrier_complete(bar, b.x, nloc, nx); b.st[0] = nloc; b.st[1] = nx; }
        const unsigned old = xb_add(&bar[XB_XSUB(b.x)], 1u);
        const unsigned gen = old / nloc;
        if (old + 1u == (gen + 1u) * nloc) {
            __builtin_amdgcn_fence(__ATOMIC_RELEASE, "agent");
            asm volatile("s_waitcnt vmcnt(0)" ::: "memory");
            const unsigned og = xb_add(&bar[XB_TOP], 1u);
            const unsigned tg = og / nx;
            if (og + 1u == (tg + 1u) * nx) xb_add(&bar[XB_TOPGEN], 1u);
            else XB_SPIN(xb_ld(&bar[XB_TOPGEN]) == tg, bar);
            __builtin_amdgcn_fence(__ATOMIC_ACQUIRE, "agent");
            xb_add(&bar[XB_XGEN(b.x)], 1u);
            asm volatile("s_waitcnt vmcnt(0)" ::: "memory");
        } else {
            XB_SPIN(xb_ld(&bar[XB_XGEN(b.x)]) == gen, bar);
            __builtin_amdgcn_fence(__ATOMIC_ACQUIRE, "agent");
            asm volatile("s_waitcnt vmcnt(0)" ::: "memory");
        }
    }
    __syncthreads();
}

constexpr int NWAVES = 8;
constexpr int TT = 8192, DM = 4096, NSRC = 16416, NPROJ = 16384;
constexpr int NEXP = 16, DEXP = 2048, CAP = 1024;
constexpr float EPS = 1e-6f;
constexpr int N_PHASES = 12;
#ifndef MK_ONE_LAUNCH
#define MK_ONE_LAUNCH 1
#endif
#ifndef PROBE_MASK
#define PROBE_MASK 0
#endif
#define REP(k) for (int rep_ = 0; rep_ <= ((PROBE_MASK >> (k)) & 1); ++rep_)

constexpr size_t MiB = 1u << 20;
constexpr size_t WS_CTL = 0, CTL_ZERO_BYTES = 1 * MiB;
constexpr size_t WS_WLOWT = 1 * MiB;
constexpr size_t WS_GLOW = 2 * MiB;
constexpr size_t WS_AFFT = 3 * MiB;
constexpr size_t WS_IDX = 3 * MiB + 512 * 1024;
constexpr size_t WS_GATEV = WS_IDX + 64 * 1024;
constexpr size_t WS_PAIR = WS_IDX + 128 * 1024;
constexpr size_t WS_SLOT = 4 * MiB;
constexpr size_t WS_WRT = 5 * MiB;
constexpr size_t WS_WINT = 8 * MiB;
constexpr size_t WS_WOUTT = 136 * MiB;
constexpr size_t WS_W13T = 168 * MiB;
constexpr size_t WS_W2T = 680 * MiB;
constexpr size_t WS_XN = 936 * MiB;
constexpr size_t WS_H = 1000 * MiB;
constexpr size_t WS_ACT = 1128 * MiB;
constexpr size_t WS_GQ = WS_ACT, WS_GK = WS_ACT + 16 * MiB, WS_GV = WS_ACT + 32 * MiB, WS_GOG = WS_ACT + 64 * MiB, WS_HQ = WS_ACT + 96 * MiB;
constexpr size_t WS_HFF = WS_ACT + 128 * MiB, WS_HFB = WS_ACT + 192 * MiB, WS_HI = WS_ACT + 256 * MiB, WS_HOG = WS_ACT + 288 * MiB;
constexpr size_t WS_QMF = WS_ACT + 320 * MiB, WS_QMB = WS_ACT + 368 * MiB, WS_KMF = WS_ACT + 416 * MiB, WS_KMB = WS_ACT + 464 * MiB;
constexpr size_t WS_OF = WS_ACT + 512 * MiB, WS_OB = WS_ACT + 576 * MiB;
constexpr size_t WS_CM = WS_ACT + 640 * MiB, WS_CL = WS_ACT + 644 * MiB;
constexpr size_t WS_XE = WS_ACT, WS_HID = WS_ACT + 128 * MiB, WS_YE = WS_ACT + 192 * MiB;
constexpr size_t WS_END = WS_ACT + 648 * MiB;
constexpr int CW_BAR = 4096;

constexpr int RING_BYTES = 131072, LDSCTL_OFF = 143360, MISC_OFF = LDSCTL_OFF + 320, LDS_BYTES = 147456;

typedef __bf16 bf2_t __attribute__((ext_vector_type(2)));
typedef float f2_t __attribute__((ext_vector_type(2)));
typedef unsigned v2u __attribute__((ext_vector_type(2)));
__device__ __forceinline__ unsigned pkbf(float lo, float hi) { f2_t v = {lo, hi}; return __builtin_bit_cast(unsigned, __builtin_convertvector(v, bf2_t)); }
__device__ __forceinline__ float bflo(unsigned w) { return __builtin_bit_cast(float, w << 16); }
__device__ __forceinline__ float bfhi(unsigned w) { return __builtin_bit_cast(float, w & 0xffff0000u); }
__device__ __forceinline__ float silu_f(float x) { return x * __builtin_amdgcn_rcpf(1.0f + __expf(-x)); }
__device__ __forceinline__ float wave_sum(float v) {
#pragma unroll
    for (int o = 1; o < 64; o <<= 1) v += __shfl_xor(v, o);
    return v;
}
__device__ __forceinline__ float clamp8(float x) { return fminf(fmaxf(x, -448.f), 448.f); }
template <int K2> __device__ __forceinline__ int fp8_mag(float x) {
    const unsigned a = __builtin_bit_cast(unsigned, x) & 0x7fffffffu;
    const int bn = (int)(a + (unsigned)(0x7ffff + (K2 << 23) - (960 << 20)) + ((a >> 20) & 1u)) >> 20;
    const int bs = (int)__builtin_rintf(fminf(__builtin_fabsf(x) * (float)(1 << (9 + K2)), 8.0f));
    const int b = bn > bs ? bn : bs; return b < 0x7e ? b : 0x7e;
}
template <int K2> __device__ __forceinline__ unsigned pk4_fp8k(float a, float b, float c, float d) {
    const unsigned ua = __builtin_bit_cast(unsigned, a), ub = __builtin_bit_cast(unsigned, b), uc = __builtin_bit_cast(unsigned, c), ud = __builtin_bit_cast(unsigned, d);
    unsigned m0 = (unsigned)fp8_mag<K2>(a), m1 = (unsigned)fp8_mag<K2>(b), m2 = (unsigned)fp8_mag<K2>(c), m3 = (unsigned)fp8_mag<K2>(d);
    asm volatile("" : "+v"(m0), "+v"(m1), "+v"(m2), "+v"(m3));
    const unsigned mg = __builtin_amdgcn_perm(__builtin_amdgcn_perm(m3, m2, 0x0c0c0400u), __builtin_amdgcn_perm(m1, m0, 0x0c0c0400u), 0x05040100u);
    const unsigned sg = (__builtin_amdgcn_perm(ub, ua, 0x0c0c0703u) | __builtin_amdgcn_perm(ud, uc, 0x07030c0cu)) & (mg + 0x7f7f7f7fu) & 0x80808080u;
    return mg | sg;
}
__device__ __forceinline__ unsigned pk4_fp8(float a, float b, float c, float d) { return pk4_fp8k<0>(a, b, c, d); }
template <int K2> __device__ __forceinline__ int fp8_mag_w(float x) {
    const unsigned a = __builtin_bit_cast(unsigned, x) & 0x7fffffffu;
    const int c = (int)(a + (unsigned)(0x7ffff + (K2 << 23) - (960 << 20)) + ((a >> 20) & 1u)) >> 20;
    const int r = c < 8 ? 0 : c; return r < 0x7e ? r : 0x7e;
}
template <int K2> __device__ __forceinline__ unsigned pk4_fp8w(float a, float b, float c, float d) {
    const unsigned ua = __builtin_bit_cast(unsigned, a), ub = __builtin_bit_cast(unsigned, b), uc = __builtin_bit_cast(unsigned, c), ud = __builtin_bit_cast(unsigned, d);
    unsigned m0 = (unsigned)fp8_mag_w<K2>(a), m1 = (unsigned)fp8_mag_w<K2>(b), m2 = (unsigned)fp8_mag_w<K2>(c), m3 = (unsigned)fp8_mag_w<K2>(d);
    asm volatile("" : "+v"(m0), "+v"(m1), "+v"(m2), "+v"(m3));
    const unsigned mg = __builtin_amdgcn_perm(__builtin_amdgcn_perm(m3, m2, 0x0c0c0400u), __builtin_amdgcn_perm(m1, m0, 0x0c0c0400u), 0x05040100u);
    const unsigned sg = (__builtin_amdgcn_perm(ub, ua, 0x0c0c0703u) | __builtin_amdgcn_perm(ud, uc, 0x07030c0cu)) & (mg + 0x7f7f7f7fu) & 0x80808080u;
    return mg | sg;
}
constexpr float W8_SCALE = 64.f, HID8_SCALE = 8.f;
#define MFMA16(a, b, c) __builtin_amdgcn_mfma_f32_16x16x32_bf16((a), (b), (c), 0, 0, 0)

__device__ __forceinline__ int fresh_lane() { int l; asm volatile("v_mbcnt_lo_u32_b32 %0, -1, 0\n\tv_mbcnt_hi_u32_b32 %0, -1, %0" : "=v"(l)); return l; }
struct Args { const float* in[18]; float* out; unsigned char* ws; int ph_lo, ph_hi; };

namespace pg8 {
struct EpiInProj {
    static constexpr bool PERM = true, AFTER_DRAIN = false;
    unsigned char* ws;
    __device__ __forceinline__ void operator()(const f32x4 (&acc)[2][2][4][2], const Unit& u, int wr, int wc, int fr, int fq) const {
        const int pn = u.pn; int mode = 0, ld = 2048, pl = 0; float sc = 1.f; size_t off = 0;
        if (pn < 4) { off = WS_GQ; ld = 1024; pl = pn; sc = 0.08838834764831845f; }
        else if (pn < 8) { off = WS_GK; ld = 1024; pl = pn - 4; }
        else if (pn < 16) { off = WS_GV; pl = pn - 8; }
        else if (pn < 24) { off = WS_GOG; pl = pn - 16; mode = 1; }
        else if (pn < 32) { off = WS_HQ; pl = pn - 24; mode = 1; sc = 0.08838834764831845f; }
        else if (pn < 40) { off = WS_HFF; pl = pn - 32; }
        else if (pn < 48) { off = WS_HFB; pl = pn - 40; }
        else if (pn < 56) { off = WS_HI; pl = pn - 48; }
        else { off = WS_HOG; pl = pn - 56; mode = 1; }
        const int row0 = u.pm * BM + wr * 64 + fr, col0 = pl * BM + wc * 32 + 8 * fq;
        if (mode == 2) {
            float* base = (float*)(ws + off);
#pragma unroll
            for (int ai = 0; ai < 2; ++ai)
#pragma unroll
                for (int m = 0; m < 4; ++m) { float* rowp = base + (size_t)(row0 + ai * HALF + m * 16) * ld + col0;
#pragma unroll
                    for (int bj = 0; bj < 2; ++bj) { *(f32x4*)(rowp + bj * HALF) = acc[ai][bj][m][0]; *(f32x4*)(rowp + bj * HALF + 4) = acc[ai][bj][m][1]; } }
        } else {
            bf16_t* base = (bf16_t*)(ws + off);
#pragma unroll
            for (int ai = 0; ai < 2; ++ai)
#pragma unroll
                for (int m = 0; m < 4; ++m) { bf16_t* rowp = base + (size_t)(row0 + ai * HALF + m * 16) * ld + col0;
#pragma unroll
                    for (int bj = 0; bj < 2; ++bj) { f32x4 v0 = acc[ai][bj][m][0], v1 = acc[ai][bj][m][1];
                        if (mode == 1) {
#pragma unroll
                            for (int j = 0; j < 4; ++j) { v0[j] = silu_f(v0[j]); v1[j] = silu_f(v1[j]); } }
                        v0 = v0 * sc; v1 = v1 * sc;
                        u32x4 w; w.x = pkbf(v0[0], v0[1]); w.y = pkbf(v0[2], v0[3]); w.z = pkbf(v1[0], v1[1]); w.w = pkbf(v1[2], v1[3]);
                        *(u32x4*)(rowp + bj * HALF) = w; } }
        }
    }
};
struct EpiResBf16 {
    static constexpr bool PERM = true, AFTER_DRAIN = false;
    const float* base; bf16_t* C; int ldc;
    __device__ __forceinline__ void operator()(const f32x4 (&acc)[2][2][4][2], const Unit& u, int wr, int wc, int fr, int fq) const {
        const int row0 = u.pm * BM + wr * 64 + fr, col0 = u.pn * BM + wc * 32 + 8 * fq;
#pragma unroll
        for (int ai = 0; ai < 2; ++ai)
#pragma unroll
            for (int m = 0; m < 4; ++m) { const size_t o = (size_t)(row0 + ai * HALF + m * 16) * ldc + col0;
#pragma unroll
                for (int bj = 0; bj < 2; ++bj) { const f32x4 v0 = acc[ai][bj][m][0] + *(const f32x4*)(base + o + bj * HALF), v1 = acc[ai][bj][m][1] + *(const f32x4*)(base + o + bj * HALF + 4);
                    u32x4 w; w.x = pkbf(v0[0], v0[1]); w.y = pkbf(v0[2], v0[3]); w.z = pkbf(v1[0], v1[1]); w.w = pkbf(v1[2], v1[3]);
                    *(u32x4*)(C + o + bj * HALF) = w; } }
    }
};
struct EpiSwiglu {
    static constexpr bool PERM = true, AFTER_DRAIN = false;
    unsigned char* HID;
    __device__ __forceinline__ void operator()(const f32x4 (&acc)[2][2][4][2], const Unit& u, int wr, int wc, int fr, int fq) const {
        const int row0 = u.pm * BM + wr * 64 + fr, col0 = (u.pn & 15) * HALF + wc * 32 + 8 * fq; constexpr float us = 1.0f / W8_SCALE;
#pragma unroll
        for (int ai = 0; ai < 2; ++ai)
#pragma unroll
            for (int m = 0; m < 4; ++m) { unsigned char* rowp = HID + (size_t)(row0 + ai * HALF + m * 16) * DEXP + col0;
                float o[8];
#pragma unroll
                for (int n = 0; n < 2; ++n)
#pragma unroll
                    for (int j = 0; j < 4; ++j) o[4 * n + j] = silu_f(acc[ai][0][m][n][j] * us) * (acc[ai][1][m][n][j] * (us * HID8_SCALE));
                v2u w; w.x = pk4_fp8(o[0], o[1], o[2], o[3]); w.y = pk4_fp8(o[4], o[5], o[6], o[7]);
                *(v2u*)rowp = w; }
    }
};
struct EpiGate {
    static constexpr bool PERM = true, AFTER_DRAIN = false;
    bf16_t* YE; const float* gate;
    __device__ __forceinline__ void operator()(const f32x4 (&acc)[2][2][4][2], const Unit& u, int wr, int wc, int fr, int fq) const {
        const int row0 = u.pm * BM + wr * 64 + fr, col0 = (u.pn & 15) * BM + wc * 32 + 8 * fq;
#pragma unroll
        for (int ai = 0; ai < 2; ++ai)
#pragma unroll
            for (int m = 0; m < 4; ++m) { const int r = row0 + ai * HALF + m * 16; const float gt = gate[r] * (1.0f / (W8_SCALE * HID8_SCALE)); bf16_t* rowp = YE + (size_t)r * DM + col0;
#pragma unroll
                for (int bj = 0; bj < 2; ++bj) { const f32x4 v0 = acc[ai][bj][m][0] * gt, v1 = acc[ai][bj][m][1] * gt;
                    u32x4 w; w.x = pkbf(v0[0], v0[1]); w.y = pkbf(v0[2], v0[3]); w.z = pkbf(v1[0], v1[1]); w.w = pkbf(v1[2], v1[3]);
                    *(u32x4*)(rowp + bj * HALF) = w; } }
    }
};
struct GroupedOrder {
    int c;
    __device__ __forceinline__ bool next(int i, Unit& u) const {
        if (i >= 4) return false;
        const int xcd = c & 7, j = c >> 3, e = 2 * xcd + (i >> 1);
        u.pm = 4 * e + (j & 3); u.pn = 16 * e + 8 * (i & 1) + (j >> 2); return true;
    }
    __device__ __forceinline__ void a_ready(const Unit&) const {}
    __device__ __forceinline__ void done(const Unit&) const {}
};
struct SubOrder {
    StaticOrder base; int i0, i1;
    __device__ __forceinline__ bool next(int i, Unit& u) const { return (i0 + i < i1) && base.next(i0 + i, u); }
    __device__ __forceinline__ void a_ready(const Unit&) const {}
    __device__ __forceinline__ void done(const Unit&) const {}
};
}

__device__ __forceinline__ void transpose_item(const float* src, size_t lds_, bf16* dst, size_t ldd, LAS float* scr, int lane) {
    const unsigned loff = (unsigned)(((size_t)(lane >> 5) * lds_ + (lane & 31)) * 4);
    float tv[32];
#pragma unroll
    for (int i = 0; i < 32; ++i) tv[i] = __builtin_nontemporal_load((const GAS float*)((const GAS unsigned char*)src + (size_t)(2 * i) * lds_ * 4 + loff));
#pragma unroll
    for (int i = 0; i < 32; ++i) scr[(2 * i + (lane >> 5)) * 33 + (lane & 31)] = tv[i];
    LDS_WAIT(); asm volatile("" ::: "memory");
    const int c = lane & 7; const unsigned soff = (unsigned)(((size_t)(lane >> 3) * ldd + 8 * c) * 2);
#pragma unroll
    for (int j = 0; j < 4; ++j) { const LAS float* s = scr + (8 * c) * 33 + (lane >> 3) + 8 * j;
        v4u o; o.x = pkbf(s[0 * 33], s[1 * 33]); o.y = pkbf(s[2 * 33], s[3 * 33]); o.z = pkbf(s[4 * 33], s[5 * 33]); o.w = pkbf(s[6 * 33], s[7 * 33]);
        __builtin_nontemporal_store(o, (GAS v4u*)((GAS unsigned char*)dst + (size_t)(8 * j) * ldd * 2 + soff)); }
    LDS_WAIT(); asm volatile("" ::: "memory");
}
__device__ __forceinline__ void rms_row_to_bf16(const float* xrow, const float* w, bf16* orow, int lane) {
    const GAS f32x4* xr = (const GAS f32x4*)xrow + lane; const GAS f32x4* wr = (const GAS f32x4*)w + lane;
    f32x4 v[16]; float s = 0.f;
#pragma unroll
    for (int j = 0; j < 16; ++j) { v[j] = xr[64 * j]; s += (v[j].x * v[j].x + v[j].y * v[j].y) + (v[j].z * v[j].z + v[j].w * v[j].w); }
    const float rstd = 1.0f / sqrtf(wave_sum(s) * (1.f / DM) + EPS);
    GAS v2u* o8 = (GAS v2u*)orow + lane;
#pragma unroll
    for (int j = 0; j < 16; ++j) { const f32x4 ww = wr[64 * j]; v2u o; o.x = pkbf(v[j].x * rstd * ww.x, v[j].y * rstd * ww.y); o.y = pkbf(v[j].z * rstd * ww.z, v[j].w * rstd * ww.w); o8[64 * j] = o; }
}
constexpr int SCR_STRIDE = 17408;
__device__ __forceinline__ void transpose_block128(const float* src, size_t lds_, bf16* dst, size_t ldd, LAS float* scr, int lane) {
    const __amdgpu_buffer_rsrc_t rs = __builtin_amdgcn_make_buffer_rsrc((void*)src, 0, 0x7fffffff, 0x00020000);
    const __amdgpu_buffer_rsrc_t rd = __builtin_amdgcn_make_buffer_rsrc((void*)dst, 0, 0x7fffffff, 0x00020000);
    float tv[128];
#pragma unroll
    for (int i = 0; i < 128; ++i) tv[i] = __builtin_bit_cast(float, __builtin_amdgcn_raw_buffer_load_b32(rs, (unsigned)(lane * 4), (unsigned)((size_t)(i >> 1) * lds_ * 4 + (i & 1) * 256), 2));
    const int sub = lane >> 5, c = lane & 7, nq = (lane >> 3) & 3;
    LAS float* scrp = scr + sub * (64 * 33);
    const unsigned soff = (unsigned)((((size_t)(32 * sub + nq)) * ldd + 8 * c) * 2);
#pragma unroll
    for (int hh = 0; hh < 2; ++hh) {
#pragma unroll
        for (int r = 0; r < 64; ++r) scrp[r * 33 + (lane & 31)] = tv[2 * r + hh];
        LDS_WAIT(); asm volatile("" ::: "memory");
#pragma unroll
        for (int j = 0; j < 8; ++j) { const LAS float* s = scrp + (8 * c) * 33 + nq + 4 * j;
            v4u o; o.x = pkbf(s[0 * 33], s[1 * 33]); o.y = pkbf(s[2 * 33], s[3 * 33]); o.z = pkbf(s[4 * 33], s[5 * 33]); o.w = pkbf(s[6 * 33], s[7 * 33]);
            __builtin_amdgcn_raw_buffer_store_b128(o, rd, soff, (unsigned)((size_t)(64 * hh + 4 * j) * ldd * 2), 2); }
        LDS_WAIT(); asm volatile("" ::: "memory");
    }
}
__device__ __forceinline__ void transpose_block128_fp8(const float* src, size_t lds_, unsigned char* dst, size_t ldd, LAS float* scr, int lane) {
    const __amdgpu_buffer_rsrc_t rs = __builtin_amdgcn_make_buffer_rsrc((void*)src, 0, 0x7fffffff, 0x00020000);
    const __amdgpu_buffer_rsrc_t rd = __builtin_amdgcn_make_buffer_rsrc((void*)dst, 0, 0x7fffffff, 0x00020000);
    float tv[128];
#pragma unroll
    for (int i = 0; i < 128; ++i) tv[i] = __builtin_bit_cast(float, __builtin_amdgcn_raw_buffer_load_b32(rs, (unsigned)(lane * 4), (unsigned)((size_t)(i >> 1) * lds_ * 4 + (i & 1) * 256), 2));
    const int sub = lane >> 5, c = lane & 3, nq = (lane >> 2) & 7;
    LAS float* scrp = scr + sub * (64 * 33);
    const unsigned soff = (unsigned)(((size_t)(32 * sub + nq)) * ldd + 16 * c);
#pragma unroll
    for (int hh = 0; hh < 2; ++hh) {
#pragma unroll
        for (int r = 0; r < 64; ++r) scrp[r * 33 + (lane & 31)] = tv[2 * r + hh];
        LDS_WAIT(); asm volatile("" ::: "memory");
#pragma unroll
        for (int j = 0; j < 4; ++j) { const LAS float* s = scrp + (16 * c) * 33 + nq + 8 * j;
            v4u o;
#pragma unroll
            for (int q = 0; q < 4; ++q) o[q] = pk4_fp8w<6>(s[(4 * q) * 33], s[(4 * q + 1) * 33], s[(4 * q + 2) * 33], s[(4 * q + 3) * 33]);
            __builtin_amdgcn_raw_buffer_store_b128(o, rd, soff, (unsigned)((size_t)(64 * hh + 8 * j) * ldd), 2); }
        LDS_WAIT(); asm volatile("" ::: "memory");
    }
}
constexpr int I_D = 16 * 1024, I_F = 16 * 1024, N_EXP_ITEMS = 2 * I_D + I_F;
constexpr int N_EXP_STATIC = 0;
constexpr int Q_CHUNKS = (N_EXP_ITEMS - N_EXP_STATIC) / NWAVES;
constexpr int CW_QHEAD = 8192, CW_P3DONE = 8256, CW_P7DONE = 8320;
__device__ __forceinline__ void conv_expert_item(const Args& a, int r, LAS float* scr, int lane) {
    const float* w1 = a.in[14]; const float* w3 = a.in[15]; const float* w2 = a.in[16];
    unsigned char* W13T = a.ws + WS_W13T; unsigned char* W2T = a.ws + WS_W2T;
    if (r < 2 * I_D) { const int is3 = r >= I_D; if (is3) r -= I_D; const int e = r >> 10, q = r & 1023, kb = q & 63, nb = q >> 6, n0 = 128 * nb, drow = nb * 256 + (is3 ? 128 : 0);
        transpose_block128_fp8((is3 ? w3 : w1) + (size_t)e * DM * DEXP + (size_t)(64 * kb) * DEXP + n0, DEXP, W13T + ((size_t)e * 4096 + drow) * DM + 64 * kb, DM, scr, lane); }
    else { r -= 2 * I_D; const int e = r >> 10, q = r & 1023, kb = q & 31, nb = q >> 5, n0 = 128 * nb;
        transpose_block128_fp8(w2 + (size_t)e * DEXP * DM + (size_t)(64 * kb) * DM + n0, DM, a.ws + WS_W2T + ((size_t)e * 4096 + n0) * DEXP + 64 * kb, DEXP, scr, lane); }
}
struct CvItem { const float* src; unsigned char* dst; unsigned lds4, ldd; };
__device__ __forceinline__ CvItem conv_expert_desc(const Args& a, int r) {
    CvItem it;
    if (r < 2 * I_D) { const int is3 = r >= I_D; if (is3) r -= I_D; const int e = r >> 10, q = r & 1023, kb = q & 63, nb = q >> 6, n0 = 128 * nb, drow = nb * 256 + (is3 ? 128 : 0);
        it.src = (is3 ? a.in[15] : a.in[14]) + (size_t)e * DM * DEXP + (size_t)(64 * kb) * DEXP + n0; it.lds4 = DEXP * 4; it.dst = a.ws + WS_W13T + ((size_t)e * 4096 + drow) * DM + 64 * kb; it.ldd = DM; }
    else { r -= 2 * I_D; const int e = r >> 10, q = r & 1023, kb = q & 31, nb = q >> 5, n0 = 128 * nb;
        it.src = a.in[16] + (size_t)e * DEXP * DM + (size_t)(64 * kb) * DM + n0; it.lds4 = DM * 4; it.dst = a.ws + WS_W2T + ((size_t)e * 4096 + n0) * DEXP + 64 * kb; it.ldd = DEXP; }
    return it;
}
#define CV_LOAD(hh, it) do { const __amdgpu_buffer_rsrc_t rs_ = __builtin_amdgcn_make_buffer_rsrc((void*)(it).src, 0, 0x7fffffff, 0x00020000); \
        _Pragma("unroll") for (int r_ = 0; r_ < 64; ++r_) tv[2 * r_ + (hh)] = __builtin_bit_cast(float, __builtin_amdgcn_raw_buffer_load_b32(rs_, (unsigned)(lane * 4), (unsigned)r_ * (it).lds4 + (hh) * 256u, 2)); } while (0)
#define CV_WRITE(hh) do { LAS float* scrp_ = scr + (lane >> 5) * (64 * 33); _Pragma("unroll") for (int r_ = 0; r_ < 64; ++r_) scrp_[r_ * 33 + (lane & 31)] = tv[2 * r_ + (hh)]; LDS_WAIT(); asm volatile("" ::: "memory"); } while (0)
#define CV_STORE(hh, it) do { const __amdgpu_buffer_rsrc_t rd_ = __builtin_amdgcn_make_buffer_rsrc((void*)(it).dst, 0, 0x7fffffff, 0x00020000); \
        const int sub_ = lane >> 5, c_ = lane & 3, nq_ = (lane >> 2) & 7; const LAS float* scrp_ = scr + sub_ * (64 * 33); const unsigned soff_ = (unsigned)((32 * sub_ + nq_) * (it).ldd + 16 * c_); \
        _Pragma("unroll") for (int j_ = 0; j_ < 4; ++j_) { const LAS float* s_ = scrp_ + (16 * c_) * 33 + nq_ + 8 * j_; v4u o_; \
            _Pragma("unroll") for (int q_ = 0; q_ < 4; ++q_) o_[q_] = pk4_fp8w<6>(s_[(4 * q_) * 33], s_[(4 * q_ + 1) * 33], s_[(4 * q_ + 2) * 33], s_[(4 * q_ + 3) * 33]);     \
            __builtin_amdgcn_raw_buffer_store_b128(o_, rd_, soff_, (unsigned)(64 * (hh) + 8 * j_) * (it).ldd, 2); } \
        LDS_WAIT(); asm volatile("" ::: "memory"); } while (0)
__device__ __forceinline__ int conv_queue_pop(const Args& a, LAS unsigned char* lds, int tid, const unsigned* stop_word, unsigned stop_at) {
    volatile LAS int* qslot = (volatile LAS int*)(lds + LDSCTL_OFF + 64);
    unsigned* ctl = (unsigned*)(a.ws + WS_CTL);
    if (tid == 0) { int q = -1;
        if (!(stop_word && __hip_atomic_load(stop_word, __ATOMIC_RELAXED, __HIP_MEMORY_SCOPE_AGENT) >= stop_at)) { q = (int)__hip_atomic_fetch_add(ctl + CW_QHEAD, 1u, __ATOMIC_RELAXED, __HIP_MEMORY_SCOPE_AGENT); if (q >= Q_CHUNKS) q = -1; }
        qslot[0] = q; }
    __syncthreads();
    const int q = qslot[0];
    __syncthreads();
    return q;
}
__device__ __forceinline__ void conv_queue_run(const Args& a, LAS unsigned char* lds, int tid, int lane, int wave, const unsigned* stop_word, unsigned stop_at) {
    LAS float* scr = (LAS float*)(lds + wave * SCR_STRIDE);
    int q0 = conv_queue_pop(a, lds, tid, stop_word, stop_at);
    if (q0 >= 0) {
        float tv[128];
        CvItem cur = conv_expert_desc(a, N_EXP_STATIC + q0 * NWAVES + wave);
        CV_LOAD(0, cur); CV_LOAD(1, cur);
        for (;;) {
            const int q1 = conv_queue_pop(a, lds, tid, stop_word, stop_at);
            CvItem nxt = cur; if (q1 >= 0) nxt = conv_expert_desc(a, N_EXP_STATIC + q1 * NWAVES + wave);
            CV_WRITE(0); if (q1 >= 0) CV_LOAD(0, nxt); CV_STORE(0, cur);
            CV_WRITE(1); if (q1 >= 0) CV_LOAD(1, nxt); CV_STORE(1, cur);
            if (q1 < 0) break;
            cur = nxt;
        }
    }
    __syncthreads();
}
__device__ __forceinline__ void p0_prologue(const Args& a, LAS unsigned char* lds, int lane, int wave, int vcu, int G) {
    LAS float* scr = (LAS float*)(lds + wave * SCR_STRIDE);
    const int gw = vcu * NWAVES + wave, NGW = G * NWAVES;
    const float* w_in = a.in[2]; const float* w_out = a.in[11];
    bf16* WINT = (bf16*)(a.ws + WS_WINT); bf16* WLOWT = (bf16*)(a.ws + WS_WLOWT); bf16* WOUTT = (bf16*)(a.ws + WS_WOUTT);
    constexpr int I_A = 64 * 128, I_B = 64, I_C = 64 * 32;
    constexpr int NITEMS = I_A + I_B + I_C + N_EXP_STATIC;
    for (int it = gw; it < NITEMS; it += NGW) {
        int r = it;
        if (r < I_A) { const int kb = r & 63, nb = r >> 6, n0 = 128 * nb, sc = n0 < 4096 ? n0 : n0 + 32;
            transpose_block128(w_in + (size_t)(64 * kb) * NSRC + sc, NSRC, WINT + (size_t)n0 * DM + 64 * kb, DM, scr, lane); continue; } r -= I_A;
        if (r < I_B) { transpose_item(w_in + (size_t)(64 * r) * NSRC + 4096, NSRC, WLOWT + 64 * r, DM, scr, lane); continue; } r -= I_B;
        if (r < I_C) { const int kb = r & 63, nb = r >> 6;
            transpose_block128(w_out + (size_t)(64 * kb) * DM + 128 * nb, DM, WOUTT + (size_t)(128 * nb) * DM + 64 * kb, DM, scr, lane); continue; } r -= I_C;
        conv_expert_item(a, r, scr, lane);
    }
    { const float* wr = a.in[13]; const float* nwf = a.in[12]; bf16* wh = (bf16*)(a.ws + WS_WRT); bf16* wl = wh + NEXP * DM;
      for (int i = gw * 64 + lane; i < DM * NEXP; i += NGW * 64) { const float v = wr[i] * nwf[i >> 4]; const unsigned h = f2bf(v); const float r = v - __builtin_bit_cast(float, h << 16);
          wh[(size_t)(i & 15) * DM + (i >> 4)] = (bf16)h; wl[(size_t)(i & 15) * DM + (i >> 4)] = (bf16)f2bf(r); } }
    const float* x = a.in[0]; const float* nw = a.in[1]; bf16* XN = (bf16*)(a.ws + WS_XN);
    for (int m = gw; m < TT; m += NGW) rms_row_to_bf16(x + (size_t)m * DM, nw, XN + (size_t)m * DM, lane);
}

typedef float f32x16 __attribute__((ext_vector_type(16)));
__device__ __forceinline__ void p1_glow(const Args& a, LAS unsigned char* lds, int tid, int lane, int wave) {
    const bf16* XN = (const bf16*)(a.ws + WS_XN); const bf16* WL = (const bf16*)(a.ws + WS_WLOWT); float* GLOW = (float*)(a.ws + WS_GLOW);
    LAS float* scr = (LAS float*)lds;
    for (int blk = blockIdx.x; blk < TT / 32; blk += gridDim.x) {
        const int r = lane & 31, h = lane >> 5;
        const bf16* ap = XN + (size_t)(32 * blk + r) * DM + 512 * wave + 8 * h; const bf16* bp = WL + (size_t)r * DM + 512 * wave + 8 * h;
        f32x16 acc; for (int i = 0; i < 16; ++i) acc[i] = 0.f;
#pragma unroll 4
        for (int s = 0; s < 32; ++s) { const bf16x8 av = *(const GAS bf16x8*)(ap + 16 * s), bv = *(const GAS bf16x8*)(bp + 16 * s);
            acc = __builtin_amdgcn_mfma_f32_32x32x16_bf16(av, bv, acc, 0, 0, 0); }
#pragma unroll
        for (int i = 0; i < 16; ++i) { const int row = (i & 3) + 8 * (i >> 2) + 4 * h; scr[(wave * 32 + row) * 33 + r] = acc[i]; }
        __syncthreads();
#pragma unroll
        for (int q = 0; q < 2; ++q) { const int o = tid + 512 * q, row = o >> 5, col = o & 31; float s = 0.f;
#pragma unroll
            for (int w = 0; w < 8; ++w) s += scr[(w * 32 + row) * 33 + col];
            GLOW[(size_t)(32 * blk + row) * 32 + col] = s; }
        __syncthreads();
    }
}

constexpr int NQK = 3072;
__device__ __forceinline__ float fast_rcp(float x) { return __builtin_amdgcn_rcpf(x); }
#define GLD(T, base, off) (*(const GAS T*)((const GAS unsigned char*)(base) + (unsigned)(off)))
#define GST(T, base, off) (*(GAS T*)((GAS unsigned char*)(base) + (unsigned)(off)))
__device__ __forceinline__ void p2_prep(const Args& a, LAS unsigned char* lds, int tid) {
    const float* GLOW = (const float*)(a.ws + WS_GLOW);
    LAS float* cumL = (LAS float*)lds;
    for (int u = blockIdx.x; u < 1536; u += gridDim.x) {
        const int c = u / 12, rem = u - 12 * c, dir = rem / 6, blk = rem - 6 * dir, n = blk * 512 + tid;
        const int rstart = dir ? 63 : 0, rstep = dir ? -1 : 1, rrmid = dir ? 31 : 32;
        unsigned char* QMb = a.ws + (dir ? WS_QMB : WS_QMF) + (size_t)(64 * c + rstart) * NQK * 2; unsigned char* KMb = a.ws + (dir ? WS_KMB : WS_KMF) + (size_t)(64 * c + rstart) * NQK * 2;
        const long qkstep = (long)rstep * NQK * 2;
        float* CM = (float*)(a.ws + WS_CM) + ((size_t)dir * 128 + c) * NQK; float* CL = (float*)(a.ws + WS_CL) + ((size_t)dir * 128 + c) * NQK;
        if (blk < 2) {
            const float* up = dir ? a.in[5] : a.in[3]; const float* bias = dir ? a.in[6] : a.in[4];
            const unsigned char* GQb = a.ws + WS_GQ + (size_t)(64 * c + rstart) * 2048; const unsigned char* GKb = a.ws + WS_GK + (size_t)(64 * c + rstart) * 2048; const long gstep = (long)rstep * 2048;
            float upr[16];
#pragma unroll
            for (int j = 0; j < 16; ++j) upr[j] = up[j * 1024 + n];
            const float b = bias[n]; float run = 0.f, cmid = 0.f;
#pragma unroll 4
            for (int rr = 0; rr < 64; ++rr) { const int t = 64 * c + rstart + rstep * rr; const f32x4* gl = (const f32x4*)(GLOW + (size_t)t * 32 + 16 * dir);
                const f32x4 g0 = gl[0], g1 = gl[1], g2 = gl[2], g3 = gl[3];
                float z = b;
#pragma unroll
                for (int j = 0; j < 4; ++j) { z = fmaf(g0[j], upr[j], z); z = fmaf(g1[j], upr[4 + j], z); z = fmaf(g2[j], upr[8 + j], z); z = fmaf(g3[j], upr[12 + j], z); }
                run += (fminf(z, 0.f) - __logf(1.0f + __expf(-fabsf(z)))) * 0.0625f; cumL[rr * 512 + tid] = run; cmid = (rr == rrmid) ? run : cmid; }
            CM[n] = cmid; CL[n] = run - cmid;
#pragma unroll
            for (int hb = 0; hb < 2; ++hb) {
                unsigned short qr[32], kr[32];
#pragma unroll
                for (int i = 0; i < 32; ++i) { qr[i] = GLD(unsigned short, GQb + (32 * hb + i) * gstep, 2 * n); kr[i] = GLD(unsigned short, GKb + (32 * hb + i) * gstep, 2 * n); }
#pragma unroll
                for (int i = 0; i < 32; ++i) { const int rr = 32 * hb + i;
                    const float q = bflo((unsigned)qr[i]), k = bflo((unsigned)kr[i]), e1 = __expf(fminf(fmaxf(cumL[rr * 512 + tid] - cmid, -80.f), 80.f)), e2 = fast_rcp(e1);
                    GST(unsigned short, QMb + rr * qkstep, 2 * n) = (unsigned short)(pkbf(q * e1, 0.f) & 0xffffu); GST(unsigned short, KMb + rr * qkstep, 2 * n) = (unsigned short)(pkbf(k * e2, 0.f) & 0xffffu); } }
        } else {
            const int nh = n - 1024; const float* lg = dir ? a.in[9] : a.in[8];
            const float lb = 1.0f / (1.0f + expf(lg[2048 + nh] - lg[nh])), olb = 1.0f - lb;
            const unsigned char* fcb = a.ws + (dir ? WS_HFB : WS_HFF) + (size_t)(64 * c + rstart) * 4096; const long fstep = (long)rstep * 4096;
            const unsigned char* HQb = a.ws + WS_HQ + (size_t)(64 * c + rstart) * 4096; const long hstep_ = (long)rstep * 4096;
            float fr[64];
#pragma unroll
            for (int rr = 0; rr < 64; ++rr) fr[rr] = bflo((unsigned)GLD(unsigned short, fcb + rr * fstep, 2 * nh));
            float run = 0.f, cmid = 0.f;
#pragma unroll
            for (int rr = 0; rr < 64; ++rr) { const float s = fast_rcp(1.0f + __expf(-fr[rr]));
                run += __logf(fmaf(olb, s, lb)); cumL[rr * 512 + tid] = run; cmid = (rr == rrmid) ? run : cmid; fr[rr] = olb * (1.0f - s); }
            CM[n] = cmid; CL[n] = run - cmid;
#pragma unroll
            for (int hb = 0; hb < 2; ++hb) {
                unsigned short qr[32];
#pragma unroll
                for (int i = 0; i < 32; ++i) qr[i] = GLD(unsigned short, HQb + (32 * hb + i) * hstep_, 2 * nh);
#pragma unroll
                for (int i = 0; i < 32; ++i) { const int rr = 32 * hb + i;
                    const float q = bflo((unsigned)qr[i]), e1 = __expf(fminf(fmaxf(cumL[rr * 512 + tid] - cmid, -80.f), 80.f)), e2 = fast_rcp(e1);
                    GST(unsigned short, QMb + rr * qkstep, 2 * n) = (unsigned short)(pkbf(q * e1, 0.f) & 0xffffu); GST(unsigned short, KMb + rr * qkstep, 2 * n) = (unsigned short)(pkbf(fr[rr] * e2, 0.f) & 0xffffu); } }
        }
    }
}

typedef short s16x4 __attribute__((ext_vector_type(4)));
constexpr int SQ_STR = 272, SV_STR = 144;
constexpr int IMG_KM = 17408, IMG_V = 34816, IMG_BYTES = 44032;
constexpr int L_P = 2 * IMG_BYTES, P_BYTES = 9216, L_F = L_P + 2 * P_BYTES, L_OX = L_F + 1024, OX_BYTES = 17408, P3_LDS_END = L_OX + 2 * OX_BYTES;
static_assert(P3_LDS_END <= LDSCTL_OFF, "P3 LDS map");
#define TR16(p) __builtin_amdgcn_ds_read_tr16_b64_v4i16((LAS s16x4*)(p))
__device__ __forceinline__ void p3_scan(const Args& a, LAS unsigned char* lds, int tid, int lane, int wave) {
    const int bxs = blockIdx.x, xq = bxs & 7, iq = bxs >> 3;
    const int job = (bxs >= 128) ? bxs : (iq < 8 ? 4 * (2 * xq + (iq >> 2)) + (iq & 3) : 64 + 2 * (4 * xq + ((iq - 8) >> 1)) + ((iq - 8) & 1));
    if (job < 128) {
        const bf16 *qp, *kp, *vp; const float *cmp_, *clp; bf16* op; int dir;
        { int colb, head, sl;
          if (job < 64) { const int seq = job >> 2; head = seq >> 1; sl = job & 3; dir = seq & 1; colb = head * 128;
              vp = (const bf16*)(a.ws + WS_GV) + head * 256 + sl * 64; op = (bf16*)(a.ws + (dir ? WS_OB : WS_OF)) + head * 256 + sl * 64; }
          else { const int jj = job - 64, seq = jj >> 1; head = seq >> 1; sl = jj & 1; dir = seq & 1; colb = 1024 + head * 128;
              vp = (const bf16*)(a.ws + WS_HI) + head * 128 + sl * 64; op = (bf16*)(a.ws + (dir ? WS_OB : WS_OF)) + 2048 + head * 128 + sl * 64; }
          qp = (const bf16*)(a.ws + (dir ? WS_QMB : WS_QMF)) + colb; kp = (const bf16*)(a.ws + (dir ? WS_KMB : WS_KMF)) + colb;
          cmp_ = (const float*)(a.ws + WS_CM) + (size_t)dir * 128 * NQK + colb; clp = (const float*)(a.ws + WS_CL) + (size_t)dir * 128 * NQK + colb; }
        const int prow = tid >> 4, pch = tid & 15;
        const int vs = tid >> 3, vo = tid & 7;
        v4u rq[2][2], rk[2][2], rv[2]; float rcm[2] = {0.f, 0.f}, rcl[2] = {0.f, 0.f};
#define P3_LOAD(S_, tau_) do { const int ci_ = dir ? 127 - (tau_) : (tau_); const size_t t0_ = (size_t)ci_ * 64; \
            _Pragma("unroll") for (int i_ = 0; i_ < 2; ++i_) { const size_t row_ = t0_ + prow + 32 * i_; \
                rq[S_][i_] = *(const GAS v4u*)(qp + row_ * NQK + 8 * pch); rk[S_][i_] = *(const GAS v4u*)(kp + row_ * NQK + 8 * pch); } \
            rv[S_] = __builtin_nontemporal_load((const GAS v4u*)(vp + (t0_ + vs) * 2048 + 8 * vo)); \
            if (tid < 128) { rcm[S_] = cmp_[(size_t)ci_ * NQK + tid]; rcl[S_] = clp[(size_t)ci_ * NQK + tid]; } } while (0)
        float carry = 0.f;
#define P3_STAGE(S_, tau_) do { LAS unsigned char* ib_ = lds + ((tau_) & 1) * IMG_BYTES; \
            _Pragma("unroll") for (int i_ = 0; i_ < 2; ++i_) { *(LAS v4u*)(ib_ + (prow + 32 * i_) * SQ_STR + 16 * pch) = rq[S_][i_]; *(LAS v4u*)(ib_ + IMG_KM + (prow + 32 * i_) * SQ_STR + 16 * pch) = rk[S_][i_]; } \
            *(LAS v4u*)(ib_ + IMG_V + vs * SV_STR + 16 * vo) = rv[S_]; \
            if (tid < 128) { ((LAS float*)(lds + L_F + ((tau_) & 1) * 512))[tid] = __expf(rcm[S_] + carry); carry = rcl[S_]; } } while (0)
        const int g = lane >> 4, c16 = lane & 15, cs = wave & 3, dh = wave >> 2, tq = c16 >> 2, tp = c16 & 3;
#define P3_SCORES(tau_) do { const LAS unsigned char* ib_ = lds + ((tau_) & 1) * IMG_BYTES; LAS unsigned char* pb_ = lds + L_P + ((tau_) & 1) * P_BYTES; \
            const int st = wave >> 1, tt0 = 2 * (wave & 1); f32x4 X0 = {0.f, 0.f, 0.f, 0.f}, X1 = {0.f, 0.f, 0.f, 0.f}; \
            _Pragma("unroll") for (int ks = 0; ks < 4; ++ks) { const bf16x8 A = *(const LAS bf16x8*)(ib_ + IMG_KM + (16 * st + c16) * SQ_STR + (32 * ks + 8 * g) * 2); \
                const bf16x8 B0 = *(const LAS bf16x8*)(ib_ + (16 * tt0 + c16) * SQ_STR + (32 * ks + 8 * g) * 2), B1 = *(const LAS bf16x8*)(ib_ + (16 * tt0 + 16 + c16) * SQ_STR + (32 * ks + 8 * g) * 2); \
                X0 = MFMA16(A, B0, X0); X1 = MFMA16(A, B1, X1); } \
            const int sb = 16 * st + 4 * g, ta = 16 * tt0 + c16, tb = ta + 16; \
            _Pragma("unroll") for (int i = 0; i < 4; ++i) { const int s = sb + i; const bool ka = dir ? (s >= ta) : (s <= ta), kb = dir ? (s >= tb) : (s <= tb); X0[i] = ka ? X0[i] : 0.f; X1[i] = kb ? X1[i] : 0.f; } \
            v2u w0, w1; w0.x = pkbf(X0[0], X0[1]); w0.y = pkbf(X0[2], X0[3]); w1.x = pkbf(X1[0], X1[1]); w1.y = pkbf(X1[2], X1[3]); \
            *(LAS v2u*)(pb_ + ta * SV_STR + sb * 2) = w0; *(LAS v2u*)(pb_ + tb * SV_STR + sb * 2) = w1; } while (0)
        f32x4 S[4];
#pragma unroll
        for (int n = 0; n < 4; ++n) S[n] = (f32x4){0.f, 0.f, 0.f, 0.f};
        P3_LOAD(0, 0); P3_STAGE(0, 0); P3_LOAD(1, 1); P3_LOAD(0, 2);
        __syncthreads();
        P3_SCORES(0);
        __syncthreads();
        for (int t2 = 0; t2 < 64; ++t2)
#pragma unroll
        for (int par = 0; par < 2; ++par) { const int tau = 2 * t2 + par;
            if (tau + 1 < 128) { P3_STAGE(1 - par, tau + 1); if (tau + 3 < 128) P3_LOAD(1 - par, tau + 3); }
            { const LAS unsigned char* ib = lds + (tau & 1) * IMG_BYTES; const LAS unsigned char* pb = lds + L_P + (tau & 1) * P_BYTES;
#pragma unroll
              for (int n = 0; n < 4; ++n) { const f32x4 f = *(const LAS f32x4*)(lds + L_F + (tau & 1) * 512 + (64 * dh + 16 * n + 4 * g) * 4); S[n] = S[n] * f; }
              bf16x8 vb[2];
#pragma unroll
              for (int ks = 0; ks < 2; ++ks) { const LAS unsigned char* va = ib + IMG_V + (32 * ks + 8 * g + tq) * SV_STR + 32 * cs + 8 * tp;
                  const s16x4 lo = TR16(va), hi = TR16(va + 4 * SV_STR); vb[ks] = __builtin_shufflevector(lo, hi, 0, 1, 2, 3, 4, 5, 6, 7); }
              f32x4 O[4];
#pragma unroll
              for (int m = 0; m < 4; ++m) O[m] = (f32x4){0.f, 0.f, 0.f, 0.f};
#pragma unroll
              for (int m = 0; m < 4; ++m) { const bf16x8 A = *(const LAS bf16x8*)(pb + (16 * m + c16) * SV_STR + (32 * dh + 8 * g) * 2); O[m] = MFMA16(A, dh ? vb[1] : vb[0], O[m]); }
#pragma unroll
              for (int p = 0; p < 2; ++p) { v4u bw; bw.x = pkbf(S[2 * p][0], S[2 * p][1]); bw.y = pkbf(S[2 * p][2], S[2 * p][3]); bw.z = pkbf(S[2 * p + 1][0], S[2 * p + 1][1]); bw.w = pkbf(S[2 * p + 1][2], S[2 * p + 1][3]);
                  const bf16x8 B = __builtin_bit_cast(bf16x8, bw);
#pragma unroll
                  for (int m = 0; m < 4; ++m) { const LAS unsigned char* qa = ib + (16 * m + c16) * SQ_STR + (64 * dh + 32 * p + 4 * g) * 2;
                      const v2u lo = *(const LAS v2u*)qa, hi = *(const LAS v2u*)(qa + 32); v4u aw; aw.x = lo.x; aw.y = lo.y; aw.z = hi.x; aw.w = hi.y;
                      O[m] = MFMA16(__builtin_bit_cast(bf16x8, aw), B, O[m]); } }
#pragma unroll
              for (int n = 0; n < 4; ++n)
#pragma unroll
                  for (int ks = 0; ks < 2; ++ks) { const LAS unsigned char* ka = ib + IMG_KM + (32 * ks + 8 * g + tq) * SQ_STR + (64 * dh + 16 * n) * 2 + 8 * tp;
                      const s16x4 lo = TR16(ka), hi = TR16(ka + 4 * SQ_STR);
                      S[n] = MFMA16(__builtin_shufflevector(lo, hi, 0, 1, 2, 3, 4, 5, 6, 7), vb[ks], S[n]); }
#pragma unroll
              for (int m = 0; m < 4; ++m)
#pragma unroll
                  for (int i = 0; i < 4; ++i) ((LAS float*)(lds + L_OX + dh * OX_BYTES))[(16 * m + 4 * g + i) * 68 + 16 * cs + c16] = O[m][i];
            }
            __syncthreads();
            if (tau + 1 < 128) P3_SCORES(tau + 1);
            { const int ci = dir ? 127 - tau : tau; const size_t t0 = (size_t)ci * 64; const int row = tid >> 3, pc = tid & 7;
              const LAS float* x0 = (const LAS float*)(lds + L_OX) + row * 68 + 8 * pc; const LAS float* x1 = (const LAS float*)(lds + L_OX + OX_BYTES) + row * 68 + 8 * pc;
              const f32x4 a0 = *(const LAS f32x4*)x0 + *(const LAS f32x4*)x1, a1 = *(const LAS f32x4*)(x0 + 4) + *(const LAS f32x4*)(x1 + 4);
              v4u w; w.x = pkbf(a0[0], a0[1]); w.y = pkbf(a0[2], a0[3]); w.z = pkbf(a1[0], a1[1]); w.w = pkbf(a1[2], a1[3]);
              *(GAS v4u*)(op + (t0 + row) * 4096 + 8 * pc) = w; }
            __syncthreads();
        }
#undef P3_LOAD
#undef P3_STAGE
#undef P3_SCORES
        if (tid == 0) __hip_atomic_fetch_add((unsigned*)(a.ws + WS_CTL) + CW_P3DONE, 1u, __ATOMIC_RELAXED, __HIP_MEMORY_SCOPE_AGENT);
    } else {
        conv_queue_run(a, lds, tid, lane, wave, (const unsigned*)(a.ws + WS_CTL) + CW_P3DONE, 128u);
    }
}


__device__ __forceinline__ void p4_combine(const Args& a, int lane, int wave, int vcu, int G) {
    const int gw = vcu * NWAVES + wave, NGW = G * NWAVES;
    const bf16* OF = (const bf16*)(a.ws + WS_OF); const bf16* OB = (const bf16*)(a.ws + WS_OB);
    const bf16* GOG = (const bf16*)(a.ws + WS_GOG); const bf16* HOG = (const bf16*)(a.ws + WS_HOG); bf16* MX = (bf16*)(a.ws + WS_XN);
    const float* gw_ = a.in[7]; const float* hw_ = a.in[10];
    float wg[8], wh[8];
#pragma unroll
    for (int j = 0; j < 8; ++j) { wg[j] = gw_[8 * (lane & 31) + j]; wh[j] = hw_[8 * (lane & 15) + j]; }
    for (int row = gw; row < TT; row += NGW) {
#pragma unroll
        for (int c = 0; c < 8; ++c) {
            const size_t o = (size_t)row * DM + 512 * c + 8 * lane;
            const v4u vf = *(const GAS v4u*)(OF + o), vb = *(const GAS v4u*)(OB + o);
            const v4u og = (c < 4) ? *(const GAS v4u*)(GOG + (size_t)row * 2048 + 512 * c + 8 * lane) : *(const GAS v4u*)(HOG + (size_t)row * 2048 + 512 * (c - 4) + 8 * lane);
            float v[8]; float ss = 0.f;
#pragma unroll
            for (int j = 0; j < 4; ++j) { v[2 * j] = bflo(vf[j]) + bflo(vb[j]); v[2 * j + 1] = bfhi(vf[j]) + bfhi(vb[j]); ss += v[2 * j] * v[2 * j] + v[2 * j + 1] * v[2 * j + 1]; }
            ss += __shfl_xor(ss, 1); ss += __shfl_xor(ss, 2); ss += __shfl_xor(ss, 4); ss += __shfl_xor(ss, 8);
            float rs;
            if (c < 4) { ss += __shfl_xor(ss, 16); rs = 1.0f / sqrtf(ss * (1.f / 256.f) + EPS); } else rs = 1.0f / sqrtf(ss * (1.f / 128.f) + EPS);
            v4u w;
#pragma unroll
            for (int j = 0; j < 4; ++j) { const float w0 = (c < 4) ? wg[2 * j] : wh[2 * j], w1 = (c < 4) ? wg[2 * j + 1] : wh[2 * j + 1];
                w[j] = pkbf(v[2 * j] * rs * w0 * bflo(og[j]), v[2 * j + 1] * rs * w1 * bfhi(og[j])); }
            *(GAS v4u*)(MX + o) = w;
        }
    }
}

__device__ __forceinline__ void p6_router(const Args& a, LAS unsigned char* lds, int wave, int vcu, int G) {
    const bf16* H = (const bf16*)(a.ws + WS_H); const float* nw = a.in[12]; const bf16* WH = (const bf16*)(a.ws + WS_WRT); const bf16* WL = WH + NEXP * DM;
    unsigned char* XN2 = a.ws + WS_XN; float* AFFT = (float*)(a.ws + WS_AFFT);
    LAS f32x4* part = (LAS f32x4*)lds; LAS float* ssw = (LAS float*)(lds + 16384); LAS float* rsl = (LAS float*)(lds + 16384 + 1024);
    const __amdgpu_buffer_rsrc_t rsW = __builtin_amdgcn_make_buffer_rsrc((void*)WH, 0, 0x7fffffff, 0x00020000), rsN = __builtin_amdgcn_make_buffer_rsrc((void*)nw, 0, 0x7fffffff, 0x00020000);
    for (int blk = vcu; blk < TT / 32; blk += G) {
        const int r0 = blk * 32;
        const int lane = fresh_lane(), tid = wave * 64 + lane;
        const int i = lane & 15, kq = lane >> 4, kb = wave * 512 + kq * 8;
        const unsigned voff = (unsigned)((i * DM + kb) * 2);
        const __amdgpu_buffer_rsrc_t rsH = __builtin_amdgcn_make_buffer_rsrc((void*)(H + (size_t)r0 * DM), 0, 0x7fffffff, 0x00020000), rsX = __builtin_amdgcn_make_buffer_rsrc((void*)(XN2 + (size_t)r0 * DM), 0, 0x7fffffff, 0x00020000);
        v4u af[2][16];
#pragma unroll
        for (int t = 0; t < 2; ++t)
#pragma unroll
            for (int s_ = 0; s_ < 16; ++s_) af[t][s_] = __builtin_bit_cast(v4u, __builtin_amdgcn_raw_buffer_load_b128(rsH, voff, (unsigned)(t * 16 * DM * 2 + s_ * 64), 0));
        f32x4 acc[2] = {{0.f, 0.f, 0.f, 0.f}, {0.f, 0.f, 0.f, 0.f}};
        __builtin_amdgcn_sched_barrier(0);
#pragma unroll
        for (int hb = 0; hb < 4; ++hb) {
            v4u bh[4], bl[4];
#pragma unroll
            for (int s_ = 0; s_ < 4; ++s_) { bh[s_] = __builtin_bit_cast(v4u, __builtin_amdgcn_raw_buffer_load_b128(rsW, voff, (unsigned)((hb * 4 + s_) * 64), 0));
                bl[s_] = __builtin_bit_cast(v4u, __builtin_amdgcn_raw_buffer_load_b128(rsW, voff, (unsigned)(NEXP * DM * 2 + (hb * 4 + s_) * 64), 0)); }
#pragma unroll
            for (int s_ = 0; s_ < 4; ++s_)
#pragma unroll
                for (int t = 0; t < 2; ++t) { acc[t] = __builtin_amdgcn_mfma_f32_16x16x32_bf16(__builtin_bit_cast(bf16x8, bh[s_]), __builtin_bit_cast(bf16x8, af[t][hb * 4 + s_]), acc[t], 0, 0, 0);
                    acc[t] = __builtin_amdgcn_mfma_f32_16x16x32_bf16(__builtin_bit_cast(bf16x8, bl[s_]), __builtin_bit_cast(bf16x8, af[t][hb * 4 + s_]), acc[t], 0, 0, 0); }
            __builtin_amdgcn_sched_barrier(0);
        }
#pragma unroll
        for (int t = 0; t < 2; ++t) { float ss = 0.f;
#pragma unroll
            for (int s_ = 0; s_ < 16; ++s_) { const v4u w = af[t][s_];
#pragma unroll
                for (int j = 0; j < 4; ++j) { const float x0 = bflo(w[j]), x1 = bfhi(w[j]); ss = fmaf(x0, x0, ss); ss = fmaf(x1, x1, ss); } }
            ss += __shfl_xor(ss, 16); ss += __shfl_xor(ss, 32);
            if (lane < 16) ssw[wave * 32 + t * 16 + lane] = ss;
            part[(wave * 2 + t) * 64 + lane] = acc[t]; }
        __syncthreads();
        { const int tok = tid >> 4, e = tid & 15, t = tok >> 4, src = (e >> 2) * 16 + (tok & 15);
          float lg = 0.f, ss = 0.f;
#pragma unroll
          for (int w = 0; w < 8; ++w) { lg += ((const LAS float*)(part + (w * 2 + t) * 64 + src))[e & 3]; ss += ssw[w * 32 + tok]; }
          const float rstd = 1.0f / sqrtf(ss * (1.f / DM) + EPS);
          lg *= rstd; float mx = lg;
          mx = fmaxf(mx, __shfl_xor(mx, 1)); mx = fmaxf(mx, __shfl_xor(mx, 2)); mx = fmaxf(mx, __shfl_xor(mx, 4)); mx = fmaxf(mx, __shfl_xor(mx, 8));
          const float ex = expf(lg - mx); float den = ex;
          den += __shfl_xor(den, 1); den += __shfl_xor(den, 2); den += __shfl_xor(den, 4); den += __shfl_xor(den, 8);
          AFFT[(size_t)e * TT + r0 + tok] = ex * (1.0f / den);
          if (e == 0) rsl[tok] = rstd; }
        __syncthreads();
#pragma unroll
        for (int t = 0; t < 2; ++t)
#pragma unroll
            for (int s_ = 0; s_ < 16; ++s_) asm volatile("" : "+v"(af[t][s_]));
#pragma unroll
        for (int t = 0; t < 2; ++t) { const float rs = rsl[t * 16 + i];
#pragma unroll
            for (int s_ = 0; s_ < 16; ++s_) { if ((s_ & 3) == 0) __builtin_amdgcn_sched_barrier(0);
                const v4u w = af[t][s_]; const f32x4 n0 = __builtin_bit_cast(f32x4, __builtin_amdgcn_raw_buffer_load_b128(rsN, (unsigned)(kb * 4), (unsigned)(s_ * 128), 0)), n1 = __builtin_bit_cast(f32x4, __builtin_amdgcn_raw_buffer_load_b128(rsN, (unsigned)(kb * 4), (unsigned)(s_ * 128 + 16), 0));
                v2u o; o.x = pk4_fp8(bflo(w[0]) * rs * n0.x, bfhi(w[0]) * rs * n0.y, bflo(w[1]) * rs * n0.z, bfhi(w[1]) * rs * n0.w);
                o.y = pk4_fp8(bflo(w[2]) * rs * n1.x, bfhi(w[2]) * rs * n1.y, bflo(w[3]) * rs * n1.z, bfhi(w[3]) * rs * n1.w);
                __builtin_amdgcn_raw_buffer_store_b64(o, rsX, voff >> 1, (unsigned)(t * 16 * DM + s_ * 32), 0); } }
        __syncthreads();
    }
}

__device__ __forceinline__ void p7_topk(const Args& a, LAS unsigned char* lds, int tid, int lane, int wave) {
    if (blockIdx.x < NEXP) {
        const int e = blockIdx.x; const float* AFFT = (const float*)(a.ws + WS_AFFT) + (size_t)e * TT;
        int* IDX = (int*)(a.ws + WS_IDX) + e * CAP; float* GATEV = (float*)(a.ws + WS_GATEV) + e * CAP; int* SLOT = (int*)(a.ws + WS_SLOT); unsigned short* PAIR = (unsigned short*)(a.ws + WS_PAIR) + e * (8 * 64 * 2);
        volatile LAS int* cnt = (volatile LAS int*)lds;
        unsigned u[16];
#pragma unroll
        for (int j = 0; j < 16; ++j) u[j] = __builtin_bit_cast(unsigned, AFFT[tid + 512 * j]);
        unsigned thr = 0u;
        for (int bit = 30; bit >= 0; --bit) {
            const unsigned cand = thr | (1u << bit); int c = 0;
#pragma unroll
            for (int j = 0; j < 16; ++j) c += __popcll(__ballot(u[j] >= cand));
            if (lane == 0) cnt[(bit & 1) * 8 + wave] = c;
            __syncthreads();
            int tot = 0;
#pragma unroll
            for (int w = 0; w < 8; ++w) tot += cnt[(bit & 1) * 8 + w];
            if (tot >= CAP) thr = cand;
        }
        __syncthreads();
        { int c = 0;
#pragma unroll
          for (int j = 0; j < 16; ++j) c += __popcll(__ballot(u[j] > thr));
          if (lane == 0) cnt[wave] = c; }
        __syncthreads();
        int n_gt = 0;
#pragma unroll
        for (int w = 0; w < 8; ++w) n_gt += cnt[w];
        const int need_eq = CAP - n_gt;
        __syncthreads();
        int base_gt = 0, base_eq = 0; const unsigned long long lt = (1ull << lane) - 1ull;
        for (int j = 0; j < 16; ++j) {
            const bool gt = u[j] > thr, eq = u[j] == thr;
            const unsigned long long bg = __ballot(gt), be = __ballot(eq);
            volatile LAS int* pb = cnt + 16 + (j & 1) * 16;
            if (lane == 0) { pb[wave] = __popcll(bg); pb[8 + wave] = __popcll(be); }
            __syncthreads();
            int wg_ = 0, we = 0, tg = 0, te = 0;
#pragma unroll
            for (int w = 0; w < 8; ++w) { const int cg = pb[w], ce = pb[8 + w]; if (w < wave) { wg_ += cg; we += ce; } tg += cg; te += ce; }
            const int gt_before = base_gt + wg_ + __popcll(bg & lt), eq_before = base_eq + we + __popcll(be & lt);
            const bool sel = gt || (eq && eq_before < need_eq);
            const int pos = gt_before + (eq_before < need_eq ? eq_before : need_eq);
            const int t = tid + 512 * j;
            if (sel) { IDX[pos] = t; GATEV[pos] = __builtin_bit_cast(float, u[j]); PAIR[(((pos >> 7) * 64 + (pos & 63)) << 1) + ((pos >> 6) & 1)] = (unsigned short)t; }
            SLOT[(size_t)t * 16 + e] = sel ? pos : -1;
            base_gt += tg; base_eq += te;
        }
        __syncthreads();
        if (tid == 0) __hip_atomic_fetch_add((unsigned*)(a.ws + WS_CTL) + CW_P7DONE, 1u, __ATOMIC_RELAXED, __HIP_MEMORY_SCOPE_AGENT);
    } else {
        conv_queue_run(a, lds, tid, lane, wave, (const unsigned*)(a.ws + WS_CTL) + CW_P7DONE, (unsigned)NEXP);
    }
}

__device__ __forceinline__ void p8_gather(const Args& a, int lane, int wave, int vcu, int G) {
    const int gw = vcu * NWAVES + wave, NGW = G * NWAVES;
    const unsigned char* XN2 = a.ws + WS_XN; unsigned char* XE = a.ws + WS_XE; const int* IDX = (const int*)(a.ws + WS_IDX);
    for (int r = gw; r < NEXP * CAP; r += NGW) { const int t = IDX[r]; const GAS v4u* s = (const GAS v4u*)(XN2 + (size_t)t * DM) + lane; GAS v4u* d = (GAS v4u*)(XE + (size_t)r * DM) + lane;
        v4u v[4];
#pragma unroll
        for (int j = 0; j < 4; ++j) v[j] = s[64 * j];
#pragma unroll
        for (int j = 0; j < 4; ++j) d[64 * j] = v[j]; }
}

__device__ __forceinline__ void p11_final(const Args& a, int lane, int wave, int vcu, int G) {
    const int gw = vcu * NWAVES + wave, NGW = G * NWAVES;
    const bf16* H = (const bf16*)(a.ws + WS_H); const bf16* YE = (const bf16*)(a.ws + WS_YE); const int* SLOT = (const int*)(a.ws + WS_SLOT); const float* nw = a.in[17];
    for (int row = gw; row < TT; row += NGW) {
        const int myslot = (lane < NEXP) ? SLOT[(size_t)row * 16 + lane] : -1;
        v2u hb[16];
#pragma unroll
        for (int j = 0; j < 16; ++j) hb[j] = *(const GAS v2u*)(H + (size_t)row * DM + 256 * j + 4 * lane);
        unsigned mask = (unsigned)(__ballot(myslot >= 0) & 0xffffull);
        f32x4 v[16];
#pragma unroll
        for (int j = 0; j < 16; ++j) v[j] = (f32x4){bflo(hb[j].x), bfhi(hb[j].x), bflo(hb[j].y), bfhi(hb[j].y)};
        while (mask) {
            const int e0 = __builtin_ctz(mask); mask &= mask - 1u; const bool two = mask != 0u; const int e1 = two ? __builtin_ctz(mask) : e0; if (two) mask &= mask - 1u;
            const int s0 = __builtin_amdgcn_readlane(myslot, e0), s1 = __builtin_amdgcn_readlane(myslot, e1);
            const bf16* y0 = YE + ((size_t)e0 * CAP + s0) * DM; const bf16* y1 = YE + ((size_t)e1 * CAP + s1) * DM;
            v2u w0[16], w1[16];
#pragma unroll
            for (int j = 0; j < 16; ++j) { w0[j] = *(const GAS v2u*)(y0 + 256 * j + 4 * lane); w1[j] = *(const GAS v2u*)(y1 + 256 * j + 4 * lane); }
            const float f1 = two ? 1.f : 0.f;
#pragma unroll
            for (int j = 0; j < 16; ++j) { v[j].x += bflo(w0[j].x) + f1 * bflo(w1[j].x); v[j].y += bfhi(w0[j].x) + f1 * bfhi(w1[j].x); v[j].z += bflo(w0[j].y) + f1 * bflo(w1[j].y); v[j].w += bfhi(w0[j].y) + f1 * bfhi(w1[j].y); }
        }
        float s = 0.f;
#pragma unroll
        for (int j = 0; j < 16; ++j) s += (v[j].x * v[j].x + v[j].y * v[j].y) + (v[j].z * v[j].z + v[j].w * v[j].w);
        const float rstd = 1.0f / sqrtf(wave_sum(s) * (1.f / DM) + EPS);
#pragma unroll
        for (int j = 0; j < 16; ++j) { const f32x4 ww = *(const GAS f32x4*)(nw + 256 * j + 4 * lane); *(GAS f32x4*)(a.out + (size_t)row * DM + 256 * j + 4 * lane) = v[j] * rstd * ww; }
    }
}

__global__ void __launch_bounds__(NWAVES * 64, 2) mk_fwd(Args args) {
    extern __shared__ __attribute__((aligned(16))) unsigned char lds_raw[];
    LAS unsigned char* lds = (LAS unsigned char*)lds_raw;
    const int tid0 = threadIdx.x, wave = __builtin_amdgcn_readfirstlane(tid0 >> 6);
#define FRESH_IDS const int lane = fresh_lane(), tid = wave * 64 + lane; (void)tid; (void)lane
    const int G = gridDim.x; const int bx = blockIdx.x; const int vcu = (G % 8 == 0) ? (bx % 8) * (G / 8) + bx / 8 : bx;
    for (int u = tid0; u < (LDS_BYTES - LDSCTL_OFF) / 4; u += NWAVES * 64) ((LAS unsigned*)(lds + LDSCTL_OFF))[u] = 0u;
    __syncthreads();
    XcdBarrier bar = xcd_barrier_post((unsigned*)(args.ws + WS_CTL) + CW_BAR, (volatile LAS unsigned*)(lds + MISC_OFF) + 8);
    const int lo = args.ph_lo, hi = args.ph_hi;
#define IN(k) (lo <= (k) && (k) < hi)
#define SEAM(k) do { if (IN(k) && hi > (k) + 1) xcd_barrier(bar); } while (0)
    if (IN(0)) REP(0) { FRESH_IDS; p0_prologue(args, lds, lane, wave, vcu, G); } SEAM(0);
    if (IN(1)) { FRESH_IDS;
        p1_glow(args, lds, tid, lane, wave);
        pg8::Gemm g{(const pg8::bf16_t*)(args.ws + WS_XN), (const pg8::bf16_t*)(args.ws + WS_WINT), TT, NPROJ, DM}; pg8::StaticOrder S; S.init(TT, NPROJ, G, bx);
        pg8::EpiInProj E{args.ws};
        pg8::gemm_phase<pg8::EpiInProj, pg8::StaticOrder, true, true>(lds, g, S, E, wave);
#if (PROBE_MASK >> 1) & 1
        pg8::gemm_phase<pg8::EpiInProj, pg8::StaticOrder, true, true>(lds, g, S, E, wave);
#endif
    } SEAM(1);
    if (IN(2)) REP(2) { FRESH_IDS; p2_prep(args, lds, tid); } SEAM(2);
    if (IN(3)) REP(3) { FRESH_IDS; p3_scan(args, lds, tid, lane, wave); } SEAM(3);
    if (IN(4)) REP(4) { FRESH_IDS; p4_combine(args, lane, wave, vcu, G); } SEAM(4);
    if (IN(5)) { FRESH_IDS;
        pg8::Gemm g{(const pg8::bf16_t*)(args.ws + WS_XN), (const pg8::bf16_t*)(args.ws + WS_WOUTT), TT, DM, DM}; pg8::StaticOrder S; S.init(TT, DM, G, bx);
        pg8::EpiResBf16 E{args.in[0], (pg8::bf16_t*)(args.ws + WS_H), DM};
        pg8::gemm_phase<pg8::EpiResBf16, pg8::StaticOrder, true, true>(lds, g, S, E, wave);
#if (PROBE_MASK >> 5) & 1
        pg8::gemm_phase<pg8::EpiResBf16, pg8::StaticOrder, true, true>(lds, g, S, E, wave);
#endif
    } SEAM(5);
    if (IN(6)) REP(6) { FRESH_IDS; p6_router(args, lds, wave, vcu, G); } SEAM(6);
    if (IN(7)) REP(7) { FRESH_IDS; p7_topk(args, lds, tid, lane, wave); conv_queue_run(args, lds, tid, lane, wave, nullptr, 0u); } SEAM(7);
    if (IN(9)) { FRESH_IDS;
        pg8::Gemm g{(const pg8::bf16_t*)(args.ws + WS_XN), (const pg8::bf16_t*)(args.ws + WS_W13T), NEXP * CAP, 4096, DM, (const int*)(args.ws + WS_PAIR)}; pg8::GroupedOrder S{bx};
        pg8::EpiSwiglu E{args.ws + WS_HID};
        pg8::gemm_phase<pg8::EpiSwiglu, pg8::GroupedOrder, true, true, true, true>(lds, g, S, E, wave);
#if (PROBE_MASK >> 9) & 1
        pg8::gemm_phase<pg8::EpiSwiglu, pg8::GroupedOrder, true, true, true, true>(lds, g, S, E, wave);
#endif
    } SEAM(9);
    if (IN(10)) { FRESH_IDS;
        pg8::Gemm g{(const pg8::bf16_t*)(args.ws + WS_HID), (const pg8::bf16_t*)(args.ws + WS_W2T), NEXP * CAP, 4096, DEXP}; pg8::GroupedOrder S{bx};
        pg8::EpiGate E{(pg8::bf16_t*)(args.ws + WS_YE), (const float*)(args.ws + WS_GATEV)};
        pg8::gemm_phase<pg8::EpiGate, pg8::GroupedOrder, true, true, false, true>(lds, g, S, E, wave);
#if (PROBE_MASK >> 10) & 1
        pg8::gemm_phase<pg8::EpiGate, pg8::GroupedOrder, true, true, false, true>(lds, g, S, E, wave);
#endif
    } SEAM(10);
    if (IN(11)) REP(11) { FRESH_IDS; p11_final(args, lane, wave, vcu, G); }
#undef IN
#undef SEAM
}

extern "C" void kernel_launch(void* const* d_in, const int* in_sizes, int n_in, void* d_out, int out_size, void* d_ws, size_t ws_size, hipStream_t stream) {
    static int grid = 0;
    if (grid == 0) {
        if (n_in != 18 || out_size != TT * DM || ws_size < WS_END) { fprintf(stderr, "kernel_launch: unexpected shapes (n_in %d, out %d, ws %zu < %zu)\n", n_in, out_size, ws_size, (size_t)WS_END); grid = -1; return; }
        int dev = 0, cus = 0, per_cu = 0;
        if (hipGetDevice(&dev) != hipSuccess || hipDeviceGetAttribute(&cus, hipDeviceAttributeMultiprocessorCount, dev) != hipSuccess) { grid = -1; return; }
        if (hipFuncSetAttribute((const void*)mk_fwd, hipFuncAttributeMaxDynamicSharedMemorySize, LDS_BYTES) != hipSuccess) { fprintf(stderr, "kernel_launch: hipFuncSetAttribute failed\n"); grid = -1; return; }
        if (hipOccupancyMaxActiveBlocksPerMultiprocessor(&per_cu, (const void*)mk_fwd, NWAVES * 64, LDS_BYTES) != hipSuccess || per_cu < 1) fprintf(stderr, "kernel_launch: occupancy query reports %d\n", per_cu);
        (void)hipGetLastError();
        grid = cus;
        if (grid != 256) fprintf(stderr, "kernel_launch: %d CUs (built for 256)\n", grid);
    }
    if (grid < 0) return;
    (void)hipMemsetAsync((char*)d_ws + WS_CTL, 0, CTL_ZERO_BYTES, stream);
    Args a{};
    for (int i = 0; i < 18; ++i) a.in[i] = (const float*)d_in[i];
    a.out = (float*)d_out; a.ws = (unsigned char*)d_ws;
#if MK_ONE_LAUNCH
    a.ph_lo = 0; a.ph_hi = N_PHASES;
    hipLaunchKernelGGL(mk_fwd, dim3(grid), dim3(NWAVES * 64), LDS_BYTES, stream, a);
#else
    for (int p = 0; p < N_PHASES; ++p) { a.ph_lo = p; a.ph_hi = p + 1; hipLaunchKernelGGL(mk_fwd, dim3(grid), dim3(NWAVES * 64), LDS_BYTES, stream, a); }
#endif
}
```

```cpp
#include <hip/hip_runtime.h>
#include <cstdio>
#include <cstdint>
namespace pg8 {
#define PG8_LAS __attribute__((address_space(3)))
typedef unsigned short bf16_t;
typedef short bf16x8 __attribute__((ext_vector_type(8)));
typedef float f32x4 __attribute__((ext_vector_type(4)));
typedef unsigned u32x4 __attribute__((ext_vector_type(4)));
typedef long i64x2 __attribute__((ext_vector_type(2)));
typedef int i32x4 __attribute__((ext_vector_type(4)));
typedef int i32x8 __attribute__((ext_vector_type(8)));
constexpr int BM = 256, BK = 64, HALF = 128, HTB = HALF * BK * 2  , STAGE_BYTES = 8 * HTB, NXCD = 8, WGM = 8;

__host__ __device__ __forceinline__ int lds_byte(int r, int c) { const int st = (r >> 4) * 2 + (c >> 5), rr = r & 15, cc = c & 31, ob = rr * 64 + cc * 2; return st * 1024 + (ob ^ (((ob >> 9) & 1) << 5)); }
__host__ __device__ __forceinline__ void stage_rc(int b, int& R, int& C) { const int st = b / 1024, sb = b % 1024, swz = sb ^ (((sb >> 9) & 1) << 5); R = (st >> 1) * 16 + swz / 64; C = (st & 1) * 32 + (swz % 64) / 2; }
__host__ __device__ __forceinline__ int perm32(int rho) { const int n = rho >> 4, i = rho & 15; return 8 * (i >> 2) + 4 * n + (i & 3); }

struct Unit { int pm, pn; };
struct Gemm { const bf16_t* A; const bf16_t* Bt; int M, N, K; const int* gidx = nullptr; };

struct StaticOrder {
    int nM, nN, nwg, G, c;
    __host__ __device__ void init(int M, int N, int G_, int c_) { nM = M / BM; nN = N / BM; nwg = nM * nN; G = G_; c = c_; }
    __host__ __device__ bool next(int i, Unit& u) const {
        const long L = (long)i * G + c; if (L >= nwg) return false;
        int wgid = (int)L; { const int q = nwg / NXCD, r = nwg % NXCD, xcd = wgid % NXCD, off = wgid / NXCD; wgid = (xcd < r ? xcd * (q + 1) : r * (q + 1) + (xcd - r) * q) + off; }
        const int nig = WGM * nN, gid = wgid / nig, fm = gid * WGM, gsz = (nM - fm) < WGM ? (nM - fm) : WGM;
        u.pm = fm + ((wgid % nig) % gsz); u.pn = (wgid % nig) / gsz; return true;
    }
    __device__ __forceinline__ void a_ready(const Unit&) const {}
    __device__ __forceinline__ void done(const Unit&) const {}
};
__device__ __forceinline__ unsigned cvt_pk_bf16(float lo, float hi) { unsigned r; asm volatile("v_cvt_pk_bf16_f32 %0, %1, %2" : "=v"(r) : "v"(lo), "v"(hi)); return r; }
typedef float f32x2 __attribute__((ext_vector_type(2)));
template <class Epi, class Sched, bool ALIGN_EPI = false, bool SP2 = false, bool GATHER = false, bool FP8 = false>
__device__ __forceinline__ void gemm_phase(PG8_LAS unsigned char* lds, const Gemm g, const Sched& S, const Epi& E, const int wid) {
    int lane; asm volatile("v_mbcnt_lo_u32_b32 %0, -1, 0\n\tv_mbcnt_hi_u32_b32 %0, -1, %0" : "=v"(lane)); const int tid = wid * 64 + lane, wr = wid >> 2, wc = wid & 3, fr = lane & 15, fq = lane >> 4;
    constexpr int ES = FP8 ? 1 : 2;
    const int K = g.K, nt = K * ES / (BK * 2);
    unsigned voffA[2], voffB[2];
#pragma unroll
    for (int i = 0; i < 2; ++i) { int R, C; stage_rc(tid * 16 + i * 8192, R, C); const int Rb = Epi::PERM ? ((R & ~31) + perm32(R & 31)) : R;
        voffA[i] = (unsigned)(R * K * ES + C * 2); voffB[i] = (unsigned)(Rb * K * ES + C * 2); }
    const __amdgpu_buffer_rsrc_t rsA = __builtin_amdgcn_make_buffer_rsrc((void*)g.A, 0, -1, 0x00020000), rsB = __builtin_amdgcn_make_buffer_rsrc((void*)g.Bt, 0, -1, 0x00020000);
    const size_t kstep = (size_t)(BK * 2);
    const size_t hstep = (size_t)HALF * K * ES;
    const size_t tstep = 2 * hstep;
    const unsigned ldsw = (unsigned)wid * 1024u;
    const int aoff = lds_byte(wr * 64 + fr, fq * 8), boff = lds_byte(wc * 32 + fr, fq * 8);
#define PG8_SA(b, h) (((b) * 2 + (h)) * HTB)
#define PG8_SB(b, h) ((4 + (b) * 2 + (h)) * HTB)
#define PG8_STAGE(bufoff, gbase, voff, RS, BASE0) do { _Pragma("unroll") for (int _i = 0; _i < 2; ++_i) { \
        if constexpr (FP8) __builtin_amdgcn_raw_ptr_buffer_load_lds(RS, (PG8_LAS void*)(lds + (bufoff) + ldsw + _i * 8192), 16, (int)(voff)[_i], (int)(unsigned)((const char*)(gbase) - (BASE0)), 0, 0); \
        else __builtin_amdgcn_global_load_lds((const unsigned*)((const char*)(gbase) + (voff)[_i]), (PG8_LAS unsigned*)(lds + (bufoff) + ldsw + _i * 8192), 16, 0, 0); } } while (0)
#define PG8_GPK(h, usenext) do { if constexpr (GATHER) { int l_; asm volatile("v_mbcnt_lo_u32_b32 %0, -1, 0\n\tv_mbcnt_hi_u32_b32 %0, -1, %0" : "=v"(l_)); \
        gpk = *(const PG8_LAS unsigned*)(lds + GTAB + ((usenext) ? nbank : bank) * 4096 + (h) * 2048 + wid * 256 + l_ * 4); } } while (0)
#define PG8_STAGE_A(bufoff, h, base_noh, usenext) do { if constexpr (GATHER) { const unsigned cc_ = voffB[0] & 127u; \
        __builtin_amdgcn_raw_ptr_buffer_load_lds(rsA, (PG8_LAS void*)(lds + (bufoff) + ldsw), 16, (int)((gpk & 0xffffu) * (unsigned)(K * ES) + cc_), (int)(unsigned)((const char*)(base_noh) - (const char*)g.A), 0, 0); \
        __builtin_amdgcn_raw_ptr_buffer_load_lds(rsA, (PG8_LAS void*)(lds + (bufoff) + ldsw + 8192), 16, (int)((gpk >> 16) * (unsigned)(K * ES) + cc_), (int)(unsigned)((const char*)(base_noh) - (const char*)g.A), 0, 0); } \
        else { PG8_STAGE(bufoff, (const char*)(base_noh) + (h) * hstep, voffA, rsA, (const char*)g.A); } } while (0)
#define PG8_GTAB_LOAD(bk, pm_) do { int l_; asm volatile("v_mbcnt_lo_u32_b32 %0, -1, 0\n\tv_mbcnt_hi_u32_b32 %0, -1, %0" : "=v"(l_)); _Pragma("unroll") for (int h_ = 0; h_ < 2; ++h_) \
        __builtin_amdgcn_raw_ptr_buffer_load_lds(rsG, (PG8_LAS void*)(lds + GTAB + (bk) * 4096 + h_ * 2048 + wid * 256), 4, (int)(l_ & 0x3c), (int)(((pm_) * 2 + h_) * 256 + (wid >> 1) * 64), 0, 0); } while (0)
#define PG8_LDA(dst, b, h) do { _Pragma("unroll") for (int m = 0; m < 4; ++m) { const bf16x8 l0_ = *(const PG8_LAS bf16x8*)(lds + PG8_SA(b, h) + aoff + m * 2048), l1_ = *(const PG8_LAS bf16x8*)(lds + PG8_SA(b, h) + aoff + m * 2048 + 1024); \
        if constexpr (FP8) dst##8[m] = __builtin_shufflevector(__builtin_bit_cast(i32x4, l0_), __builtin_bit_cast(i32x4, l1_), 0, 1, 2, 3, 4, 5, 6, 7); else { dst[m][0] = l0_; dst[m][1] = l1_; } } } while (0)
#define PG8_LDB(dst, b, h) do { _Pragma("unroll") for (int n = 0; n < 2; ++n) { const bf16x8 l0_ = *(const PG8_LAS bf16x8*)(lds + PG8_SB(b, h) + boff + n * 2048), l1_ = *(const PG8_LAS bf16x8*)(lds + PG8_SB(b, h) + boff + n * 2048 + 1024); \
        if constexpr (FP8) dst##8[n] = __builtin_shufflevector(__builtin_bit_cast(i32x4, l0_), __builtin_bit_cast(i32x4, l1_), 0, 1, 2, 3, 4, 5, 6, 7); else { dst[n][0] = l0_; dst[n][1] = l1_; } } } while (0)
#define PG8_MMA(ai, bj, At, Bt) do { __builtin_amdgcn_s_setprio(1); \
        if constexpr (FP8) { _Pragma("unroll") for (int m = 0; m < 4; ++m) _Pragma("unroll") for (int n = 0; n < 2; ++n) \
            acc[ai][bj][m][n] = __builtin_amdgcn_mfma_scale_f32_16x16x128_f8f6f4(Bt##8[n], At##8[m], acc[ai][bj][m][n], 0, 0, 0, 0x7f7f7f7f, 0, 0x7f7f7f7f); } \
        else { _Pragma("unroll") for (int m = 0; m < 4; ++m) _Pragma("unroll") for (int n = 0; n < 2; ++n) _Pragma("unroll") for (int k = 0; k < 2; ++k) \
            acc[ai][bj][m][n] = __builtin_amdgcn_mfma_f32_16x16x32_bf16(Bt[n][k], At[m][k], acc[ai][bj][m][n], 0, 0, 0); } __builtin_amdgcn_s_setprio(0); } while (0)
#define PG8_WAIT_V(n) asm volatile("s_waitcnt vmcnt(" #n ")" ::: "memory")
#define PG8_WAIT_L(n) asm volatile("s_waitcnt lgkmcnt(" #n ")" ::: "memory")
#define PG8_BAR __builtin_amdgcn_s_barrier()
#define PG8_SCHED __builtin_amdgcn_sched_barrier(0)
    Unit cur, nxt; int ui = 0;
    if (!S.next(0, cur)) return;
    f32x4 acc[2][2][4][2];
#pragma unroll
    for (int a = 0; a < 2; ++a)
#pragma unroll
        for (int b = 0; b < 2; ++b)
#pragma unroll
            for (int m = 0; m < 4; ++m)
#pragma unroll
                for (int n = 0; n < 2; ++n) acc[a][b][m][n] = (f32x4){0.f, 0.f, 0.f, 0.f};
    bf16x8 At[4][2], B0[2][2], B1[2][2]; i32x8 At8[4], B08[2], B18[2];
    const char* cA = GATHER ? (const char*)g.A : (const char*)g.A + (size_t)cur.pm * tstep; const char* cB = (const char*)g.Bt + (size_t)cur.pn * tstep;
    static_assert(!GATHER || FP8, "GATHER: e4m3 operands only");
    constexpr int GTAB = 8 * HTB;
    const __amdgpu_buffer_rsrc_t rsG = __builtin_amdgcn_make_buffer_rsrc((void*)(GATHER ? (const void*)g.gidx : (const void*)g.A), 0, -1, 0x00020000);
    int bank = 0, nbank = 0; unsigned gpk = 0u; (void)bank; (void)nbank; (void)gpk; (void)rsG;
    if constexpr (GATHER) { PG8_GTAB_LOAD(0, cur.pm); PG8_WAIT_V(0); }
    S.a_ready(cur);
    if constexpr (SP2) {
        PG8_STAGE(PG8_SB(0, 0), cB, voffB, rsB, (const char*)g.Bt); PG8_STAGE(PG8_SB(0, 1), cB + hstep, voffB, rsB, (const char*)g.Bt); PG8_GPK(0, false); PG8_STAGE_A(PG8_SA(0, 0), 0, cA, false); PG8_GPK(1, false); PG8_STAGE_A(PG8_SA(0, 1), 1, cA, false);
        if (wr == 1) PG8_BAR;
        PG8_WAIT_V(2); PG8_BAR;
        PG8_STAGE(PG8_SB(1, 0), cB + kstep, voffB, rsB, (const char*)g.Bt); PG8_GPK(0, false); PG8_STAGE_A(PG8_SA(1, 0), 0, cA + kstep, false); PG8_STAGE(PG8_SB(1, 1), cB + hstep + kstep, voffB, rsB, (const char*)g.Bt);
        PG8_WAIT_V(6); PG8_BAR;
        PG8_GPK(1, false);
    } else {
        PG8_STAGE(PG8_SB(0, 0), cB, voffB, rsB, (const char*)g.Bt); PG8_STAGE_A(PG8_SA(0, 0), 0, cA, false); PG8_STAGE(PG8_SB(0, 1), cB + hstep, voffB, rsB, (const char*)g.Bt); PG8_STAGE_A(PG8_SA(0, 1), 1, cA, false);
        if (wr == 1) PG8_BAR;
        PG8_WAIT_V(4); PG8_BAR;
        PG8_STAGE(PG8_SB(1, 0), cB + kstep, voffB, rsB, (const char*)g.Bt); PG8_STAGE_A(PG8_SA(1, 0), 0, cA + kstep, false); PG8_STAGE(PG8_SB(1, 1), cB + hstep + kstep, voffB, rsB, (const char*)g.Bt);
        PG8_WAIT_V(6); PG8_BAR;
    }
    for (;;) {
        const bool has_next = S.next(ui + 1, nxt);
        const char* nA = (has_next && !GATHER) ? (const char*)g.A + (size_t)nxt.pm * tstep : cA;
        if constexpr (GATHER) { nbank = has_next ? bank ^ 1 : bank; if (has_next) PG8_GTAB_LOAD(bank ^ 1, nxt.pm); }
        const char* nB = has_next ? (const char*)g.Bt + (size_t)nxt.pn * tstep : cB;
        for (int t = 0; t < nt; t += 2) {
            const bool last = (t == nt - 2);
            const char* a1 = cA + (size_t)(t + 1) * kstep;
            const char* a2 = last ? nA : cA + (size_t)(t + 2) * kstep; const char* b2 = last ? nB : cB + (size_t)(t + 2) * kstep;
            const char* a3 = a2 + kstep; const char* b3 = b2 + kstep;
            if (last && has_next) S.a_ready(nxt);
            if constexpr (SP2) {
            PG8_LDB(B0, 0, 0); PG8_LDB(B1, 0, 1); PG8_SCHED; PG8_LDA(At, 0, 0); PG8_STAGE_A(PG8_SA(1, 1), 1, a1, false); PG8_GPK(0, last);
            PG8_WAIT_V(8); PG8_WAIT_L(0); PG8_BAR; PG8_MMA(0, 0, At, B0); PG8_MMA(0, 1, At, B1); PG8_BAR; PG8_SCHED;
            PG8_LDA(At, 0, 1); PG8_STAGE(PG8_SB(0, 0), b2, voffB, rsB, (const char*)g.Bt); PG8_STAGE(PG8_SB(0, 1), b2 + hstep, voffB, rsB, (const char*)g.Bt); PG8_STAGE_A(PG8_SA(0, 0), 0, a2, last); PG8_GPK(1, last);
            PG8_WAIT_V(8); PG8_WAIT_L(0); PG8_BAR; PG8_MMA(1, 0, At, B0); PG8_MMA(1, 1, At, B1); PG8_BAR; PG8_SCHED;
            PG8_LDB(B0, 1, 0); PG8_LDB(B1, 1, 1); PG8_SCHED; PG8_LDA(At, 1, 0); PG8_STAGE_A(PG8_SA(0, 1), 1, a2, last); PG8_GPK(0, last);
            PG8_WAIT_V(8); PG8_WAIT_L(0); PG8_BAR; PG8_MMA(0, 0, At, B0); PG8_MMA(0, 1, At, B1); PG8_BAR; PG8_SCHED;
            PG8_LDA(At, 1, 1); PG8_STAGE(PG8_SB(1, 0), b3, voffB, rsB, (const char*)g.Bt); PG8_STAGE(PG8_SB(1, 1), b3 + hstep, voffB, rsB, (const char*)g.Bt); PG8_STAGE_A(PG8_SA(1, 0), 0, a3, last); PG8_GPK(1, last);
            PG8_WAIT_V(8); PG8_WAIT_L(0); PG8_BAR; PG8_MMA(1, 0, At, B0); PG8_MMA(1, 1, At, B1); PG8_BAR; PG8_SCHED;
            } else {
            PG8_LDB(B0, 0, 0); PG8_SCHED; PG8_LDA(At, 0, 0); PG8_STAGE_A(PG8_SA(1, 1), 1, a1, false);
            PG8_WAIT_L(8); PG8_BAR; PG8_WAIT_L(0); PG8_MMA(0, 0, At, B0); PG8_BAR; PG8_SCHED;
            PG8_LDB(B1, 0, 1); PG8_STAGE(PG8_SB(0, 0), b2, voffB, rsB, (const char*)g.Bt);
            PG8_BAR; PG8_WAIT_L(0); PG8_MMA(0, 1, At, B1); PG8_BAR;
            PG8_LDA(At, 0, 1); PG8_STAGE_A(PG8_SA(0, 0), 0, a2, last);
            PG8_BAR; PG8_WAIT_L(0); PG8_MMA(1, 0, At, B0); PG8_BAR; PG8_SCHED;
            PG8_STAGE(PG8_SB(0, 1), b2 + hstep, voffB, rsB, (const char*)g.Bt);
            PG8_WAIT_V(6); PG8_BAR; PG8_MMA(1, 1, At, B1); PG8_BAR;
            PG8_LDB(B0, 1, 0); PG8_SCHED; PG8_LDA(At, 1, 0); PG8_STAGE_A(PG8_SA(0, 1), 1, a2, last);
            PG8_WAIT_L(8); PG8_BAR; PG8_WAIT_L(0); PG8_MMA(0, 0, At, B0); PG8_BAR; PG8_SCHED;
            PG8_LDB(B1, 1, 1); PG8_STAGE(PG8_SB(1, 0), b3, voffB, rsB, (const char*)g.Bt);
            PG8_BAR; PG8_WAIT_L(0); PG8_MMA(0, 1, At, B1); PG8_BAR;
            PG8_LDA(At, 1, 1); PG8_STAGE_A(PG8_SA(1, 0), 0, a3, last);
            PG8_BAR; PG8_WAIT_L(0); PG8_MMA(1, 0, At, B0); PG8_BAR; PG8_SCHED;
            PG8_STAGE(PG8_SB(1, 1), b3 + hstep, voffB, rsB, (const char*)g.Bt);
            PG8_WAIT_V(6); PG8_BAR; PG8_MMA(1, 1, At, B1); PG8_BAR;
            }
        }
        if constexpr (ALIGN_EPI) { if (wr == 0) PG8_BAR; }
        if constexpr (!Epi::AFTER_DRAIN) { E(acc, cur, wr, wc, fr, fq); S.done(cur); }
        if (!has_next) break;
#pragma unroll
        for (int a = 0; a < 2; ++a)
#pragma unroll
            for (int b = 0; b < 2; ++b)
#pragma unroll
                for (int m = 0; m < 4; ++m)
#pragma unroll
                    for (int n = 0; n < 2; ++n) acc[a][b][m][n] = (f32x4){0.f, 0.f, 0.f, 0.f};
        cur = nxt; cA = nA; cB = nB; ++ui;
        if constexpr (GATHER) bank ^= 1;
        if constexpr (ALIGN_EPI) { if (wr == 1) PG8_BAR; }
    }
    PG8_WAIT_V(0);
    if constexpr (!ALIGN_EPI) { if (wr == 0) PG8_BAR; }
    PG8_BAR;
    if constexpr (Epi::AFTER_DRAIN) { E.fused(acc, cur, wr, wc, fr, fq, lds, wid, lane); S.done(cur); }
#undef PG8_SA
#undef PG8_SB
#undef PG8_STAGE
#undef PG8_STAGE_A
#undef PG8_GPK
#undef PG8_GTAB_LOAD
#undef PG8_LDA
#undef PG8_LDB
#undef PG8_MMA
#undef PG8_WAIT_V
#undef PG8_WAIT_L
#undef PG8_BAR
#undef PG8_SCHED
}
}
#define GAS __attribute__((address_space(1)))
#define LAS __attribute__((address_space(3)))
typedef unsigned short bf16;
typedef unsigned v4u __attribute__((ext_vector_type(4)));
typedef float f32x4 __attribute__((ext_vector_type(4)));
typedef short bf16x8 __attribute__((ext_vector_type(8)));
typedef GAS unsigned gu32;
typedef GAS unsigned long long gu64;
#define RLX_AGENT __ATOMIC_RELAXED, __HIP_MEMORY_SCOPE_AGENT
#define LDS_WAIT() asm volatile("s_waitcnt lgkmcnt(0)" ::: "memory")
#define VM_WAIT() asm volatile("s_waitcnt vmcnt(0)" ::: "memory")
__device__ __forceinline__ unsigned long long rt() { return __builtin_amdgcn_s_memrealtime(); }
__device__ __forceinline__ unsigned f2bf(float f) { unsigned u = __builtin_bit_cast(unsigned, f); return (u + 0x7fffu + ((u >> 16) & 1u)) >> 16; }
__device__ __forceinline__ unsigned pk2(float lo, float hi) { return f2bf(lo) | (f2bf(hi) << 16); }
#define XB_TMO      128
#define XB_XCNT(j)  (256  + 64 * (j))
#define XB_XSUB(j)  (1280 + 64 * (j))
#define XB_XGEN(j)  (2304 + 64 * (j))
#define XB_TOP      3328
#define XB_TOPGEN   3392
#define XCD_BAR_WORDS 3456
#define XB_SPIN_CAP (1u << 18)

__device__ __forceinline__ unsigned xb_ld(unsigned* p)              { return __hip_atomic_load(p, __ATOMIC_RELAXED, __HIP_MEMORY_SCOPE_AGENT); }
__device__ __forceinline__ unsigned xb_add(unsigned* p, unsigned v) { return __hip_atomic_fetch_add(p, v, __ATOMIC_RELAXED, __HIP_MEMORY_SCOPE_AGENT); }
__device__ __forceinline__ unsigned xb_xcc_id() { return (unsigned)__builtin_amdgcn_s_getreg((3 << 11) | 20) & 0xFu; }
#define XB_SPIN(cond, bar) do { unsigned _sp = 0; while (cond) { __builtin_amdgcn_s_sleep(1); \
    if ((++_sp & 255u) == 0u) { if (xb_ld(&(bar)[XB_TMO])) break; if (_sp > XB_SPIN_CAP) { atomicAdd(&(bar)[XB_TMO], 1u); break; } } } } while (0)

struct XcdBarrier {
    unsigned* bar; unsigned x;
    volatile LAS unsigned* st;
};

__device__ __forceinline__ XcdBarrier xcd_barrier_post(unsigned* bar, volatile LAS unsigned* st) {
    XcdBarrier b; b.bar = bar; b.x = xb_xcc_id(); b.st = st;
    if (threadIdx.x == 0) (void)xb_add(&bar[XB_XCNT(b.x)], 1u);
    return b;
}
__device__ __forceinline__ void xcd_barrier_complete(unsigned* bar, unsigned x, unsigned& nloc, unsigned& nx) {
    const unsigned G = gridDim.x * gridDim.y * gridDim.z;
    unsigned sum, cnt, mine, sp = 0u;
    for (;;) {
        sum = 0u; cnt = 0u; mine = 0u;
#pragma unroll
        for (unsigned j = 0; j < 16; ++j) { const unsigned c = xb_ld(&bar[XB_XCNT(j)]); sum += c; cnt += (c > 0u) ? 1u : 0u; mine = (j == x) ? c : mine; }
        if (sum == G) break;
        __builtin_amdgcn_s_sleep(1);
        if ((++sp & 255u) == 0u) { if (xb_ld(&bar[XB_TMO])) break; if (sp > XB_SPIN_CAP) { atomicAdd(&bar[XB_TMO], 1u); break; } }
    }
    nloc = mine > 0u ? mine : 1u; nx = cnt > 0u ? cnt : 1u;
}

__device__ __forceinline__ void xcd_barrier(const XcdBarrier& b) {
    asm volatile("s_waitcnt vmcnt(0)" ::: "memory");
    __syncthreads();
    if (threadIdx.x == 0) {
        unsigned* bar = b.bar;
        __builtin_amdgcn_s_waitcnt(0);
        unsigned nloc = b.st[0], nx = b.st[1];
        if (nloc == 0u) { xcd_barrier_complete(bar, b.x, nloc, nx); b.st[0] = nloc; b.st[1] = nx; }
        const unsigned old = xb_add(&bar[XB_XSUB(b.x)], 1u);
        const unsigned gen = old / nloc;
        if (old + 1u == (gen + 1u) * nloc) {
            __builtin_amdgcn_fence(__ATOMIC_RELEASE, "agent");
            asm volatile("s_waitcnt vmcnt(0)" ::: "memory");
            const unsigned og = xb_add(&bar[XB_TOP], 1u);
            const unsigned tg = og / nx;
            if (og + 1u == (tg + 1u) * nx) xb_add(&bar[XB_TOPGEN], 1u);
            else XB_SPIN(xb_ld(&bar[XB_TOPGEN]) == tg, bar);
            __builtin_amdgcn_fence(__ATOMIC_ACQUIRE, "agent");
            xb_add(&bar[XB_XGEN(b.x)], 1u);
            asm volatile("s_waitcnt vmcnt(0)" ::: "memory");
        } else {
            XB_SPIN(xb_ld(&bar[XB_XGEN(b.x)]) == gen, bar);
            __builtin_amdgcn_fence(__ATOMIC_ACQUIRE, "agent");
            asm volatile("s_waitcnt vmcnt(0)" ::: "memory");
        }
    }
    __syncthreads();
}

constexpr int NWAVES = 8;
constexpr int TT = 8192, DM = 4096, NSRC = 16416, NPROJ = 16384;
constexpr int NEXP = 16, DEXP = 2048, CAP = 1024;
constexpr float EPS = 1e-6f;
constexpr int N_PHASES = 12;
#ifndef MK_ONE_LAUNCH
#define MK_ONE_LAUNCH 1
#endif
#ifndef PROBE_MASK
#define PROBE_MASK 0
#endif
#define REP(k) for (int rep_ = 0; rep_ <= ((PROBE_MASK >> (k)) & 1); ++rep_)

constexpr size_t MiB = 1u << 20;
constexpr size_t WS_CTL = 0, CTL_ZERO_BYTES = 1 * MiB;
constexpr size_t WS_WLOWT = 1 * MiB;
constexpr size_t WS_GLOW = 2 * MiB;
constexpr size_t WS_AFFT = 3 * MiB;
constexpr size_t WS_IDX = 3 * MiB + 512 * 1024;
constexpr size_t WS_GATEV = WS_IDX + 64 * 1024;
constexpr size_t WS_PAIR = WS_IDX + 128 * 1024;
constexpr size_t WS_SLOT = 4 * MiB;
constexpr size_t WS_WRT = 5 * MiB;
constexpr size_t WS_WINT = 8 * MiB;
constexpr size_t WS_WOUTT = 136 * MiB;
constexpr size_t WS_W13T = 168 * MiB;
constexpr size_t WS_W2T = 680 * MiB;
constexpr size_t WS_XN = 936 * MiB;
constexpr size_t WS_H = 1000 * MiB;
constexpr size_t WS_ACT = 1128 * MiB;
constexpr size_t WS_GQ = WS_ACT, WS_GK = WS_ACT + 16 * MiB, WS_GV = WS_ACT + 32 * MiB, WS_GOG = WS_ACT + 64 * MiB, WS_HQ = WS_ACT + 96 * MiB;
constexpr size_t WS_HFF = WS_ACT + 128 * MiB, WS_HFB = WS_ACT + 192 * MiB, WS_HI = WS_ACT + 256 * MiB, WS_HOG = WS_ACT + 288 * MiB;
constexpr size_t WS_QMF = WS_ACT + 320 * MiB, WS_QMB = WS_ACT + 368 * MiB, WS_KMF = WS_ACT + 416 * MiB, WS_KMB = WS_ACT + 464 * MiB;
constexpr size_t WS_OF = WS_ACT + 512 * MiB, WS_OB = WS_ACT + 576 * MiB;
constexpr size_t WS_CM = WS_ACT + 640 * MiB, WS_CL = WS_ACT + 644 * MiB;
constexpr size_t WS_XE = WS_ACT, WS_HID = WS_ACT + 128 * MiB, WS_YE = WS_ACT + 192 * MiB;
constexpr size_t WS_END = WS_ACT + 648 * MiB;
constexpr int CW_BAR = 4096;

constexpr int RING_BYTES = 131072, LDSCTL_OFF = 143360, MISC_OFF = LDSCTL_OFF + 320, LDS_BYTES = 147456;

typedef __bf16 bf2_t __attribute__((ext_vector_type(2)));
typedef float f2_t __attribute__((ext_vector_type(2)));
typedef unsigned v2u __attribute__((ext_vector_type(2)));
__device__ __forceinline__ unsigned pkbf(float lo, float hi) { f2_t v = {lo, hi}; return __builtin_bit_cast(unsigned, __builtin_convertvector(v, bf2_t)); }
__device__ __forceinline__ float bflo(unsigned w) { return __builtin_bit_cast(float, w << 16); }
__device__ __forceinline__ float bfhi(unsigned w) { return __builtin_bit_cast(float, w & 0xffff0000u); }
__device__ __forceinline__ float silu_f(float x) { return x * __builtin_amdgcn_rcpf(1.0f + __expf(-x)); }
__device__ __forceinline__ float wave_sum(float v) {
#pragma unroll
    for (int o = 1; o < 64; o <<= 1) v += __shfl_xor(v, o);
    return v;
}
__device__ __forceinline__ float clamp8(float x) { return fminf(fmaxf(x, -448.f), 448.f); }
template <int K2> __device__ __forceinline__ int fp8_mag(float x) {
    const unsigned a = __builtin_bit_cast(unsigned, x) & 0x7fffffffu;
    const int bn = (int)(a + (unsigned)(0x7ffff + (K2 << 23) - (960 << 20)) + ((a >> 20) & 1u)) >> 20;
    const int bs = (int)__builtin_rintf(fminf(__builtin_fabsf(x) * (float)(1 << (9 + K2)), 8.0f));
    const int b = bn > bs ? bn : bs; return b < 0x7e ? b : 0x7e;
}
template <int K2> __device__ __forceinline__ unsigned pk4_fp8k(float a, float b, float c, float d) {
    const unsigned ua = __builtin_bit_cast(unsigned, a), ub = __builtin_bit_cast(unsigned, b), uc = __builtin_bit_cast(unsigned, c), ud = __builtin_bit_cast(unsigned, d);
    unsigned m0 = (unsigned)fp8_mag<K2>(a), m1 = (unsigned)fp8_mag<K2>(b), m2 = (unsigned)fp8_mag<K2>(c), m3 = (unsigned)fp8_mag<K2>(d);
    asm volatile("" : "+v"(m0), "+v"(m1), "+v"(m2), "+v"(m3));
    const unsigned mg = __builtin_amdgcn_perm(__builtin_amdgcn_perm(m3, m2, 0x0c0c0400u), __builtin_amdgcn_perm(m1, m0, 0x0c0c0400u), 0x05040100u);
    const unsigned sg = (__builtin_amdgcn_perm(ub, ua, 0x0c0c0703u) | __builtin_amdgcn_perm(ud, uc, 0x07030c0cu)) & (mg + 0x7f7f7f7fu) & 0x80808080u;
    return mg | sg;
}
__device__ __forceinline__ unsigned pk4_fp8(float a, float b, float c, float d) { return pk4_fp8k<0>(a, b, c, d); }
template <int K2> __device__ __forceinline__ int fp8_mag_w(float x) {
    const unsigned a = __builtin_bit_cast(unsigned, x) & 0x7fffffffu;
    const int c = (int)(a + (unsigned)(0x7ffff + (K2 << 23) - (960 << 20)) + ((a >> 20) & 1u)) >> 20;
    const int r = c < 8 ? 0 : c; return r < 0x7e ? r : 0x7e;
}
template <int K2> __device__ __forceinline__ unsigned pk4_fp8w(float a, float b, float c, float d) {
    const unsigned ua = __builtin_bit_cast(unsigned, a), ub = __builtin_bit_cast(unsigned, b), uc = __builtin_bit_cast(unsigned, c), ud = __builtin_bit_cast(unsigned, d);
    unsigned m0 = (unsigned)fp8_mag_w<K2>(a), m1 = (unsigned)fp8_mag_w<K2>(b), m2 = (unsigned)fp8_mag_w<K2>(c), m3 = (unsigned)fp8_mag_w<K2>(d);
    asm volatile("" : "+v"(m0), "+v"(m1), "+v"(m2), "+v"(m3));
    const unsigned mg = __builtin_amdgcn_perm(__builtin_amdgcn_perm(m3, m2, 0x0c0c0400u), __builtin_amdgcn_perm(m1, m0, 0x0c0c0400u), 0x05040100u);
    const unsigned sg = (__builtin_amdgcn_perm(ub, ua, 0x0c0c0703u) | __builtin_amdgcn_perm(ud, uc, 0x07030c0cu)) & (mg + 0x7f7f7f7fu) & 0x80808080u;
    return mg | sg;
}
constexpr float W8_SCALE = 64.f, HID8_SCALE = 8.f;
#define MFMA16(a, b, c) __builtin_amdgcn_mfma_f32_16x16x32_bf16((a), (b), (c), 0, 0, 0)

__device__ __forceinline__ int fresh_lane() { int l; asm volatile("v_mbcnt_lo_u32_b32 %0, -1, 0\n\tv_mbcnt_hi_u32_b32 %0, -1, %0" : "=v"(l)); return l; }
struct Args { const float* in[18]; float* out; unsigned char* ws; int ph_lo, ph_hi; };

namespace pg8 {
struct EpiInProj {
    static constexpr bool PERM = true, AFTER_DRAIN = false;
    unsigned char* ws;
    __device__ __forceinline__ void operator()(const f32x4 (&acc)[2][2][4][2], const Unit& u, int wr, int wc, int fr, int fq) const {
        const int pn = u.pn; int mode = 0, ld = 2048, pl = 0; float sc = 1.f; size_t off = 0;
        if (pn < 4) { off = WS_GQ; ld = 1024; pl = pn; sc = 0.08838834764831845f; }
        else if (pn < 8) { off = WS_GK; ld = 1024; pl = pn - 4; }
        else if (pn < 16) { off = WS_GV; pl = pn - 8; }
        else if (pn < 24) { off = WS_GOG; pl = pn - 16; mode = 1; }
        else if (pn < 32) { off = WS_HQ; pl = pn - 24; mode = 1; sc = 0.08838834764831845f; }
        else if (pn < 40) { off = WS_HFF; pl = pn - 32; }
        else if (pn < 48) { off = WS_HFB; pl = pn - 40; }
        else if (pn < 56) { off = WS_HI; pl = pn - 48; }
        else { off = WS_HOG; pl = pn - 56; mode = 1; }
        const int row0 = u.pm * BM + wr * 64 + fr, col0 = pl * BM + wc * 32 + 8 * fq;
        if (mode == 2) {
            float* base = (float*)(ws + off);
#pragma unroll
            for (int ai = 0; ai < 2; ++ai)
#pragma unroll
                for (int m = 0; m < 4; ++m) { float* rowp = base + (size_t)(row0 + ai * HALF + m * 16) * ld + col0;
#pragma unroll
                    for (int bj = 0; bj < 2; ++bj) { *(f32x4*)(rowp + bj * HALF) = acc[ai][bj][m][0]; *(f32x4*)(rowp + bj * HALF + 4) = acc[ai][bj][m][1]; } }
        } else {
            bf16_t* base = (bf16_t*)(ws + off);
#pragma unroll
            for (int ai = 0; ai < 2; ++ai)
#pragma unroll
                for (int m = 0; m < 4; ++m) { bf16_t* rowp = base + (size_t)(row0 + ai * HALF + m * 16) * ld + col0;
#pragma unroll
                    for (int bj = 0; bj < 2; ++bj) { f32x4 v0 = acc[ai][bj][m][0], v1 = acc[ai][bj][m][1];
                        if (mode == 1) {
#pragma unroll
                            for (int j = 0; j < 4; ++j) { v0[j] = silu_f(v0[j]); v1[j] = silu_f(v1[j]); } }
                        v0 = v0 * sc; v1 = v1 * sc;
                        u32x4 w; w.x = pkbf(v0[0], v0[1]); w.y = pkbf(v0[2], v0[3]); w.z = pkbf(v1[0], v1[1]); w.w = pkbf(v1[2], v1[3]);
                        *(u32x4*)(rowp + bj * HALF) = w; } }
        }
    }
};
struct EpiResBf16 {
    static constexpr bool PERM = true, AFTER_DRAIN = false;
    const float* base; bf16_t* C; int ldc;
    __device__ __forceinline__ void operator()(const f32x4 (&acc)[2][2][4][2], const Unit& u, int wr, int wc, int fr, int fq) const {
        const int row0 = u.pm * BM + wr * 64 + fr, col0 = u.pn * BM + wc * 32 + 8 * fq;
#pragma unroll
        for (int ai = 0; ai < 2; ++ai)
#pragma unroll
            for (int m = 0; m < 4; ++m) { const size_t o = (size_t)(row0 + ai * HALF + m * 16) * ldc + col0;
#pragma unroll
                for (int bj = 0; bj < 2; ++bj) { const f32x4 v0 = acc[ai][bj][m][0] + *(const f32x4*)(base + o + bj * HALF), v1 = acc[ai][bj][m][1] + *(const f32x4*)(base + o + bj * HALF + 4);
                    u32x4 w; w.x = pkbf(v0[0], v0[1]); w.y = pkbf(v0[2], v0[3]); w.z = pkbf(v1[0], v1[1]); w.w = pkbf(v1[2], v1[3]);
                    *(u32x4*)(C + o + bj * HALF) = w; } }
    }
};
struct EpiSwiglu {
    static constexpr bool PERM = true, AFTER_DRAIN = false;
    unsigned char* HID;
    __device__ __forceinline__ void operator()(const f32x4 (&acc)[2][2][4][2], const Unit& u, int wr, int wc, int fr, int fq) const {
        const int row0 = u.pm * BM + wr * 64 + fr, col0 = (u.pn & 15) * HALF + wc * 32 + 8 * fq; constexpr float us = 1.0f / W8_SCALE;
#pragma unroll
        for (int ai = 0; ai < 2; ++ai)
#pragma unroll
            for (int m = 0; m < 4; ++m) { unsigned char* rowp = HID + (size_t)(row0 + ai * HALF + m * 16) * DEXP + col0;
                float o[8];
#pragma unroll
                for (int n = 0; n < 2; ++n)
#pragma unroll
                    for (int j = 0; j < 4; ++j) o[4 * n + j] = silu_f(acc[ai][0][m][n][j] * us) * (acc[ai][1][m][n][j] * (us * HID8_SCALE));
                v2u w; w.x = pk4_fp8(o[0], o[1], o[2], o[3]); w.y = pk4_fp8(o[4], o[5], o[6], o[7]);
                *(v2u*)rowp = w; }
    }
};
struct EpiGate {
    static constexpr bool PERM = true, AFTER_DRAIN = false;
    bf16_t* YE; const float* gate;
    __device__ __forceinline__ void operator()(const f32x4 (&acc)[2][2][4][2], const Unit& u, int wr, int wc, int fr, int fq) const {
        const int row0 = u.pm * BM + wr * 64 + fr, col0 = (u.pn & 15) * BM + wc * 32 + 8 * fq;
#pragma unroll
        for (int ai = 0; ai < 2; ++ai)
#pragma unroll
            for (int m = 0; m < 4; ++m) { const int r = row0 + ai * HALF + m * 16; const float gt = gate[r] * (1.0f / (W8_SCALE * HID8_SCALE)); bf16_t* rowp = YE + (size_t)r * DM + col0;
#pragma unroll
                for (int bj = 0; bj < 2; ++bj) { const f32x4 v0 = acc[ai][bj][m][0] * gt, v1 = acc[ai][bj][m][1] * gt;
                    u32x4 w; w.x = pkbf(v0[0], v0[1]); w.y = pkbf(v0[2], v0[3]); w.z = pkbf(v1[0], v1[1]); w.w = pkbf(v1[2], v1[3]);
                    *(u32x4*)(rowp + bj * HALF) = w; } }
    }
};
struct GroupedOrder {
    int c;
    __device__ __forceinline__ bool next(int i, Unit& u) const {
        if (i >= 4) return false;
        const int xcd = c & 7, j = c >> 3, e = 2 * xcd + (i >> 1);
        u.pm = 4 * e + (j & 3); u.pn = 16 * e + 8 * (i & 1) + (j >> 2); return true;
    }
    __device__ __forceinline__ void a_ready(const Unit&) const {}
    __device__ __forceinline__ void done(const Unit&) const {}
};
struct SubOrder {
    StaticOrder base; int i0, i1;
    __device__ __forceinline__ bool next(int i, Unit& u) const { return (i0 + i < i1) && base.next(i0 + i, u); }
    __device__ __forceinline__ void a_ready(const Unit&) const {}
    __device__ __forceinline__ void done(const Unit&) const {}
};
}

__device__ __forceinline__ void transpose_item(const float* src, size_t lds_, bf16* dst, size_t ldd, LAS float* scr, int lane) {
    const unsigned loff = (unsigned)(((size_t)(lane >> 5) * lds_ + (lane & 31)) * 4);
    float tv[32];
#pragma unroll
    for (int i = 0; i < 32; ++i) tv[i] = __builtin_nontemporal_load((const GAS float*)((const GAS unsigned char*)src + (size_t)(2 * i) * lds_ * 4 + loff));
#pragma unroll
    for (int i = 0; i < 32; ++i) scr[(2 * i + (lane >> 5)) * 33 + (lane & 31)] = tv[i];
    LDS_WAIT(); asm volatile("" ::: "memory");
    const int c = lane & 7; const unsigned soff = (unsigned)(((size_t)(lane >> 3) * ldd + 8 * c) * 2);
#pragma unroll
    for (int j = 0; j < 4; ++j) { const LAS float* s = scr + (8 * c) * 33 + (lane >> 3) + 8 * j;
        v4u o; o.x = pkbf(s[0 * 33], s[1 * 33]); o.y = pkbf(s[2 * 33], s[3 * 33]); o.z = pkbf(s[4 * 33], s[5 * 33]); o.w = pkbf(s[6 * 33], s[7 * 33]);
        __builtin_nontemporal_store(o, (GAS v4u*)((GAS unsigned char*)dst + (size_t)(8 * j) * ldd * 2 + soff)); }
    LDS_WAIT(); asm volatile("" ::: "memory");
}
__device__ __forceinline__ void rms_row_to_bf16(const float* xrow, const float* w, bf16* orow, int lane) {
    const GAS f32x4* xr = (const GAS f32x4*)xrow + lane; const GAS f32x4* wr = (const GAS f32x4*)w + lane;
    f32x4 v[16]; float s = 0.f;
#pragma unroll
    for (int j = 0; j < 16; ++j) { v[j] = xr[64 * j]; s += (v[j].x * v[j].x + v[j].y * v[j].y) + (v[j].z * v[j].z + v[j].w * v[j].w); }
    const float rstd = 1.0f / sqrtf(wave_sum(s) * (1.f / DM) + EPS);
    GAS v2u* o8 = (GAS v2u*)orow + lane;
#pragma unroll
    for (int j = 0; j < 16; ++j) { const f32x4 ww = wr[64 * j]; v2u o; o.x = pkbf(v[j].x * rstd * ww.x, v[j].y * rstd * ww.y); o.y = pkbf(v[j].z * rstd * ww.z, v[j].w * rstd * ww.w); o8[64 * j] = o; }
}
constexpr int SCR_STRIDE = 17408;
__device__ __forceinline__ void transpose_block128(const float* src, size_t lds_, bf16* dst, size_t ldd, LAS float* scr, int lane) {
    const __amdgpu_buffer_rsrc_t rs = __builtin_amdgcn_make_buffer_rsrc((void*)src, 0, 0x7fffffff, 0x00020000);
    const __amdgpu_buffer_rsrc_t rd = __builtin_amdgcn_make_buffer_rsrc((void*)dst, 0, 0x7fffffff, 0x00020000);
    float tv[128];
#pragma unroll
    for (int i = 0; i < 128; ++i) tv[i] = __builtin_bit_cast(float, __builtin_amdgcn_raw_buffer_load_b32(rs, (unsigned)(lane * 4), (unsigned)((size_t)(i >> 1) * lds_ * 4 + (i & 1) * 256), 2));
    const int sub = lane >> 5, c = lane & 7, nq = (lane >> 3) & 3;
    LAS float* scrp = scr + sub * (64 * 33);
    const unsigned soff = (unsigned)((((size_t)(32 * sub + nq)) * ldd + 8 * c) * 2);
#pragma unroll
    for (int hh = 0; hh < 2; ++hh) {
#pragma unroll
        for (int r = 0; r < 64; ++r) scrp[r * 33 + (lane & 31)] = tv[2 * r + hh];
        LDS_WAIT(); asm volatile("" ::: "memory");
#pragma unroll
        for (int j = 0; j < 8; ++j) { const LAS float* s = scrp + (8 * c) * 33 + nq + 4 * j;
            v4u o; o.x = pkbf(s[0 * 33], s[1 * 33]); o.y = pkbf(s[2 * 33], s[3 * 33]); o.z = pkbf(s[4 * 33], s[5 * 33]); o.w = pkbf(s[6 * 33], s[7 * 33]);
            __builtin_amdgcn_raw_buffer_store_b128(o, rd, soff, (unsigned)((size_t)(64 * hh + 4 * j) * ldd * 2), 2); }
        LDS_WAIT(); asm volatile("" ::: "memory");
    }
}
__device__ __forceinline__ void transpose_block128_fp8(const float* src, size_t lds_, unsigned char* dst, size_t ldd, LAS float* scr, int lane) {
    const __amdgpu_buffer_rsrc_t rs = __builtin_amdgcn_make_buffer_rsrc((void*)src, 0, 0x7fffffff, 0x00020000);
    const __amdgpu_buffer_rsrc_t rd = __builtin_amdgcn_make_buffer_rsrc((void*)dst, 0, 0x7fffffff, 0x00020000);
    float tv[128];
#pragma unroll
    for (int i = 0; i < 128; ++i) tv[i] = __builtin_bit_cast(float, __builtin_amdgcn_raw_buffer_load_b32(rs, (unsigned)(lane * 4), (unsigned)((size_t)(i >> 1) * lds_ * 4 + (i & 1) * 256), 2));
    const int sub = lane >> 5, c = lane & 3, nq = (lane >> 2) & 7;
    LAS float* scrp = scr + sub * (64 * 33);
    const unsigned soff = (unsigned)(((size_t)(32 * sub + nq)) * ldd + 16 * c);
#pragma unroll
    for (int hh = 0; hh < 2; ++hh) {
#pragma unroll
        for (int r = 0; r < 64; ++r) scrp[r * 33 + (lane & 31)] = tv[2 * r + hh];
        LDS_WAIT(); asm volatile("" ::: "memory");
#pragma unroll
        for (int j = 0; j < 4; ++j) { const LAS float* s = scrp + (16 * c) * 33 + nq + 8 * j;
            v4u o;
#pragma unroll
            for (int q = 0; q < 4; ++q) o[q] = pk4_fp8w<6>(s[(4 * q) * 33], s[(4 * q + 1) * 33], s[(4 * q + 2) * 33], s[(4 * q + 3) * 33]);
            __builtin_amdgcn_raw_buffer_store_b128(o, rd, soff, (unsigned)((size_t)(64 * hh + 8 * j) * ldd), 2); }
        LDS_WAIT(); asm volatile("" ::: "memory");
    }
}
constexpr int I_D = 16 * 1024, I_F = 16 * 1024, N_EXP_ITEMS = 2 * I_D + I_F;
constexpr int N_EXP_STATIC = 0;
constexpr int Q_CHUNKS = (N_EXP_ITEMS - N_EXP_STATIC) / NWAVES;
constexpr int CW_QHEAD = 8192, CW_P3DONE = 8256, CW_P7DONE = 8320;
__device__ __forceinline__ void conv_expert_item(const Args& a, int r, LAS float* scr, int lane) {
    const float* w1 = a.in[14]; const float* w3 = a.in[15]; const float* w2 = a.in[16];
    unsigned char* W13T = a.ws + WS_W13T; unsigned char* W2T = a.ws + WS_W2T;
    if (r < 2 * I_D) { const int is3 = r >= I_D; if (is3) r -= I_D; const int e = r >> 10, q = r & 1023, kb = q & 63, nb = q >> 6, n0 = 128 * nb, drow = nb * 256 + (is3 ? 128 : 0);
        transpose_block128_fp8((is3 ? w3 : w1) + (size_t)e * DM * DEXP + (size_t)(64 * kb) * DEXP + n0, DEXP, W13T + ((size_t)e * 4096 + drow) * DM + 64 * kb, DM, scr, lane); }
    else { r -= 2 * I_D; const int e = r >> 10, q = r & 1023, kb = q & 31, nb = q >> 5, n0 = 128 * nb;
        transpose_block128_fp8(w2 + (size_t)e * DEXP * DM + (size_t)(64 * kb) * DM + n0, DM, a.ws + WS_W2T + ((size_t)e * 4096 + n0) * DEXP + 64 * kb, DEXP, scr, lane); }
}
struct CvItem { const float* src; unsigned char* dst; unsigned lds4, ldd; };
__device__ __forceinline__ CvItem conv_expert_desc(const Args& a, int r) {
    CvItem it;
    if (r < 2 * I_D) { const int is3 = r >= I_D; if (is3) r -= I_D; const int e = r >> 10, q = r & 1023, kb = q & 63, nb = q >> 6, n0 = 128 * nb, drow = nb * 256 + (is3 ? 128 : 0);
        it.src = (is3 ? a.in[15] : a.in[14]) + (size_t)e * DM * DEXP + (size_t)(64 * kb) * DEXP + n0; it.lds4 = DEXP * 4; it.dst = a.ws + WS_W13T + ((size_t)e * 4096 + drow) * DM + 64 * kb; it.ldd = DM; }
    else { r -= 2 * I_D; const int e = r >> 10, q = r & 1023, kb = q & 31, nb = q >> 5, n0 = 128 * nb;
        it.src = a.in[16] + (size_t)e * DEXP * DM + (size_t)(64 * kb) * DM + n0; it.lds4 = DM * 4; it.dst = a.ws + WS_W2T + ((size_t)e * 4096 + n0) * DEXP + 64 * kb; it.ldd = DEXP; }
    return it;
}
#define CV_LOAD(hh, it) do { const __amdgpu_buffer_rsrc_t rs_ = __builtin_amdgcn_make_buffer_rsrc((void*)(it).src, 0, 0x7fffffff, 0x00020000); \
        _Pragma("unroll") for (int r_ = 0; r_ < 64; ++r_) tv[2 * r_ + (hh)] = __builtin_bit_cast(float, __builtin_amdgcn_raw_buffer_load_b32(rs_, (unsigned)(lane * 4), (unsigned)r_ * (it).lds4 + (hh) * 256u, 2)); } while (0)
#define CV_WRITE(hh) do { LAS float* scrp_ = scr + (lane >> 5) * (64 * 33); _Pragma("unroll") for (int r_ = 0; r_ < 64; ++r_) scrp_[r_ * 33 + (lane & 31)] = tv[2 * r_ + (hh)]; LDS_WAIT(); asm volatile("" ::: "memory"); } while (0)
#define CV_STORE(hh, it) do { const __amdgpu_buffer_rsrc_t rd_ = __builtin_amdgcn_make_buffer_rsrc((void*)(it).dst, 0, 0x7fffffff, 0x00020000); \
        const int sub_ = lane >> 5, c_ = lane & 3, nq_ = (lane >> 2) & 7; const LAS float* scrp_ = scr + sub_ * (64 * 33); const unsigned soff_ = (unsigned)((32 * sub_ + nq_) * (it).ldd + 16 * c_); \
        _Pragma("unroll") for (int j_ = 0; j_ < 4; ++j_) { const LAS float* s_ = scrp_ + (16 * c_) * 33 + nq_ + 8 * j_; v4u o_; \
            _Pragma("unroll") for (int q_ = 0; q_ < 4; ++q_) o_[q_] = pk4_fp8w<6>(s_[(4 * q_) * 33], s_[(4 * q_ + 1) * 33], s_[(4 * q_ + 2) * 33], s_[(4 * q_ + 3) * 33]);     \
            __builtin_amdgcn_raw_buffer_store_b128(o_, rd_, soff_, (unsigned)(64 * (hh) + 8 * j_) * (it).ldd, 2); } \
        LDS_WAIT(); asm volatile("" ::: "memory"); } while (0)
__device__ __forceinline__ int conv_queue_pop(const Args& a, LAS unsigned char* lds, int tid, const unsigned* stop_word, unsigned stop_at) {
    volatile LAS int* qslot = (volatile LAS int*)(lds + LDSCTL_OFF + 64);
    unsigned* ctl = (unsigned*)(a.ws + WS_CTL);
    if (tid == 0) { int q = -1;
        if (!(stop_word && __hip_atomic_load(stop_word, __ATOMIC_RELAXED, __HIP_MEMORY_SCOPE_AGENT) >= stop_at)) { q = (int)__hip_atomic_fetch_add(ctl + CW_QHEAD, 1u, __ATOMIC_RELAXED, __HIP_MEMORY_SCOPE_AGENT); if (q >= Q_CHUNKS) q = -1; }
        qslot[0] = q; }
    __syncthreads();
    const int q = qslot[0];
    __syncthreads();
    return q;
}
__device__ __forceinline__ void conv_queue_run(const Args& a, LAS unsigned char* lds, int tid, int lane, int wave, const unsigned* stop_word, unsigned stop_at) {
    LAS float* scr = (LAS float*)(lds + wave * SCR_STRIDE);
    int q0 = conv_queue_pop(a, lds, tid, stop_word, stop_at);
    if (q0 >= 0) {
        float tv[128];
        CvItem cur = conv_expert_desc(a, N_EXP_STATIC + q0 * NWAVES + wave);
        CV_LOAD(0, cur); CV_LOAD(1, cur);
        for (;;) {
            const int q1 = conv_queue_pop(a, lds, tid, stop_word, stop_at);
            CvItem nxt = cur; if (q1 >= 0) nxt = conv_expert_desc(a, N_EXP_STATIC + q1 * NWAVES + wave);
            CV_WRITE(0); if (q1 >= 0) CV_LOAD(0, nxt); CV_STORE(0, cur);
            CV_WRITE(1); if (q1 >= 0) CV_LOAD(1, nxt); CV_STORE(1, cur);
            if (q1 < 0) break;
            cur = nxt;
        }
    }
    __syncthreads();
}
__device__ __forceinline__ void p0_prologue(const Args& a, LAS unsigned char* lds, int lane, int wave, int vcu, int G) {
    LAS float* scr = (LAS float*)(lds + wave * SCR_STRIDE);
    const int gw = vcu * NWAVES + wave, NGW = G * NWAVES;
    const float* w_in = a.in[2]; const float* w_out = a.in[11];
    bf16* WINT = (bf16*)(a.ws + WS_WINT); bf16* WLOWT = (bf16*)(a.ws + WS_WLOWT); bf16* WOUTT = (bf16*)(a.ws + WS_WOUTT);
    constexpr int I_A = 64 * 128, I_B = 64, I_C = 64 * 32;
    constexpr int NITEMS = I_A + I_B + I_C + N_EXP_STATIC;
    for (int it = gw; it < NITEMS; it += NGW) {
        int r = it;
        if (r < I_A) { const int kb = r & 63, nb = r >> 6, n0 = 128 * nb, sc = n0 < 4096 ? n0 : n0 + 32;
            transpose_block128(w_in + (size_t)(64 * kb) * NSRC + sc, NSRC, WINT + (size_t)n0 * DM + 64 * kb, DM, scr, lane); continue; } r -= I_A;
        if (r < I_B) { transpose_item(w_in + (size_t)(64 * r) * NSRC + 4096, NSRC, WLOWT + 64 * r, DM, scr, lane); continue; } r -= I_B;
        if (r < I_C) { const int kb = r & 63, nb = r >> 6;
            transpose_block128(w_out + (size_t)(64 * kb) * DM + 128 * nb, DM, WOUTT + (size_t)(128 * nb) * DM + 64 * kb, DM, scr, lane); continue; } r -= I_C;
        conv_expert_item(a, r, scr, lane);
    }
    { const float* wr = a.in[13]; const float* nwf = a.in[12]; bf16* wh = (bf16*)(a.ws + WS_WRT); bf16* wl = wh + NEXP * DM;
      for (int i = gw * 64 + lane; i < DM * NEXP; i += NGW * 64) { const float v = wr[i] * nwf[i >> 4]; const unsigned h = f2bf(v); const float r = v - __builtin_bit_cast(float, h << 16);
          wh[(size_t)(i & 15) * DM + (i >> 4)] = (bf16)h; wl[(size_t)(i & 15) * DM + (i >> 4)] = (bf16)f2bf(r); } }
    const float* x = a.in[0]; const float* nw = a.in[1]; bf16* XN = (bf16*)(a.ws + WS_XN);
    for (int m = gw; m < TT; m += NGW) rms_row_to_bf16(x + (size_t)m * DM, nw, XN + (size_t)m * DM, lane);
}

typedef float f32x16 __attribute__((ext_vector_type(16)));
__device__ __forceinline__ void p1_glow(const Args& a, LAS unsigned char* lds, int tid, int lane, int wave) {
    const bf16* XN = (const bf16*)(a.ws + WS_XN); const bf16* WL = (const bf16*)(a.ws + WS_WLOWT); float* GLOW = (float*)(a.ws + WS_GLOW);
    LAS float* scr = (LAS float*)lds;
    for (int blk = blockIdx.x; blk < TT / 32; blk += gridDim.x) {
        const int r = lane & 31, h = lane >> 5;
        const bf16* ap = XN + (size_t)(32 * blk + r) * DM + 512 * wave + 8 * h; const bf16* bp = WL + (size_t)r * DM + 512 * wave + 8 * h;
        f32x16 acc; for (int i = 0; i < 16; ++i) acc[i] = 0.f;
#pragma unroll 4
        for (int s = 0; s < 32; ++s) { const bf16x8 av = *(const GAS bf16x8*)(ap + 16 * s), bv = *(const GAS bf16x8*)(bp + 16 * s);
            acc = __builtin_amdgcn_mfma_f32_32x32x16_bf16(av, bv, acc, 0, 0, 0); }
#pragma unroll
        for (int i = 0; i < 16; ++i) { const int row = (i & 3) + 8 * (i >> 2) + 4 * h; scr[(wave * 32 + row) * 33 + r] = acc[i]; }
        __syncthreads();
#pragma unroll
        for (int q = 0; q < 2; ++q) { const int o = tid + 512 * q, row = o >> 5, col = o & 31; float s = 0.f;
#pragma unroll
            for (int w = 0; w < 8; ++w) s += scr[(w * 32 + row) * 33 + col];
            GLOW[(size_t)(32 * blk + row) * 32 + col] = s; }
        __syncthreads();
    }
}

constexpr int NQK = 3072;
__device__ __forceinline__ float fast_rcp(float x) { return __builtin_amdgcn_rcpf(x); }
#define GLD(T, base, off) (*(const GAS T*)((const GAS unsigned char*)(base) + (unsigned)(off)))
#define GST(T, base, off) (*(GAS T*)((GAS unsigned char*)(base) + (unsigned)(off)))
__device__ __forceinline__ void p2_prep(const Args& a, LAS unsigned char* lds, int tid) {
    const float* GLOW = (const float*)(a.ws + WS_GLOW);
    LAS float* cumL = (LAS float*)lds;
    for (int u = blockIdx.x; u < 1536; u += gridDim.x) {
        const int c = u / 12, rem = u - 12 * c, dir = rem / 6, blk = rem - 6 * dir, n = blk * 512 + tid;
        const int rstart = dir ? 63 : 0, rstep = dir ? -1 : 1, rrmid = dir ? 31 : 32;
        unsigned char* QMb = a.ws + (dir ? WS_QMB : WS_QMF) + (size_t)(64 * c + rstart) * NQK * 2; unsigned char* KMb = a.ws + (dir ? WS_KMB : WS_KMF) + (size_t)(64 * c + rstart) * NQK * 2;
        const long qkstep = (long)rstep * NQK * 2;
        float* CM = (float*)(a.ws + WS_CM) + ((size_t)dir * 128 + c) * NQK; float* CL = (float*)(a.ws + WS_CL) + ((size_t)dir * 128 + c) * NQK;
        if (blk < 2) {
            const float* up = dir ? a.in[5] : a.in[3]; const float* bias = dir ? a.in[6] : a.in[4];
            const unsigned char* GQb = a.ws + WS_GQ + (size_t)(64 * c + rstart) * 2048; const unsigned char* GKb = a.ws + WS_GK + (size_t)(64 * c + rstart) * 2048; const long gstep = (long)rstep * 2048;
            float upr[16];
#pragma unroll
            for (int j = 0; j < 16; ++j) upr[j] = up[j * 1024 + n];
            const float b = bias[n]; float run = 0.f, cmid = 0.f;
#pragma unroll 4
            for (int rr = 0; rr < 64; ++rr) { const int t = 64 * c + rstart + rstep * rr; const f32x4* gl = (const f32x4*)(GLOW + (size_t)t * 32 + 16 * dir);
                const f32x4 g0 = gl[0], g1 = gl[1], g2 = gl[2], g3 = gl[3];
                float z = b;
#pragma unroll
                for (int j = 0; j < 4; ++j) { z = fmaf(g0[j], upr[j], z); z = fmaf(g1[j], upr[4 + j], z); z = fmaf(g2[j], upr[8 + j], z); z = fmaf(g3[j], upr[12 + j], z); }
                run += (fminf(z, 0.f) - __logf(1.0f + __expf(-fabsf(z)))) * 0.0625f; cumL[rr * 512 + tid] = run; cmid = (rr == rrmid) ? run : cmid; }
            CM[n] = cmid; CL[n] = run - cmid;
            for (int hb = 0; hb < 2; ++hb) {
                unsigned short qr[32], kr[32];
#pragma unroll
                for (int i = 0; i < 32; ++i) { qr[i] = GLD(unsigned short, GQb + (32 * hb + i) * gstep, 2 * n); kr[i] = GLD(unsigned short, GKb + (32 * hb + i) * gstep, 2 * n); }
#pragma unroll
                for (int i = 0; i < 32; ++i) { const int rr = 32 * hb + i;
                    const float q = bflo((unsigned)qr[i]), k = bflo((unsigned)kr[i]), e1 = __expf(fminf(fmaxf(cumL[rr * 512 + tid] - cmid, -80.f), 80.f)), e2 = fast_rcp(e1);
                    GST(unsigned short, QMb + rr * qkstep, 2 * n) = (unsigned short)(pkbf(q * e1, 0.f) & 0xffffu); GST(unsigned short, KMb + rr * qkstep, 2 * n) = (unsigned short)(pkbf(k * e2, 0.f) & 0xffffu); } }
        } else {
            const int nh = n - 1024; const float* lg = dir ? a.in[9] : a.in[8];
            const float lb = 1.0f / (1.0f + expf(lg[2048 + nh] - lg[nh])), olb = 1.0f - lb;
            const unsigned char* fcb = a.ws + (dir ? WS_HFB : WS_HFF) + (size_t)(64 * c + rstart) * 4096; const long fstep = (long)rstep * 4096;
            const unsigned char* HQb = a.ws + WS_HQ + (size_t)(64 * c + rstart) * 4096; const long hstep_ = (long)rstep * 4096;
            float fr[64];
#pragma unroll
            for (int rr = 0; rr < 64; ++rr) fr[rr] = bflo((unsigned)GLD(unsigned short, fcb + rr * fstep, 2 * nh));
            float run = 0.f, cmid = 0.f;
#pragma unroll
            for (int rr = 0; rr < 64; ++rr) { const float s = fast_rcp(1.0f + __expf(-fr[rr]));
                run += __logf(fmaf(olb, s, lb)); cumL[rr * 512 + tid] = run; cmid = (rr == rrmid) ? run : cmid; fr[rr] = olb * (1.0f - s); }
            CM[n] = cmid; CL[n] = run - cmid;
#pragma unroll
            for (int hb = 0; hb < 2; ++hb) {
                unsigned short qr[32];
#pragma unroll
                for (int i = 0; i < 32; ++i) qr[i] = GLD(unsigned short, HQb + (32 * hb + i) * hstep_, 2 * nh);
#pragma unroll
                for (int i = 0; i < 32; ++i) { const int rr = 32 * hb + i;
                    const float q = bflo((unsigned)qr[i]), e1 = __expf(fminf(fmaxf(cumL[rr * 512 + tid] - cmid, -80.f), 80.f)), e2 = fast_rcp(e1);
                    GST(unsigned short, QMb + rr * qkstep, 2 * n) = (unsigned short)(pkbf(q * e1, 0.f) & 0xffffu); GST(unsigned short, KMb + rr * qkstep, 2 * n) = (unsigned short)(pkbf(fr[rr] * e2, 0.f) & 0xffffu); } }
        }
    }
}

typedef short s16x4 __attribute__((ext_vector_type(4)));
constexpr int SQ_STR = 272, SV_STR = 144;
constexpr int IMG_KM = 17408, IMG_V = 34816, IMG_BYTES = 44032;
constexpr int L_P = 2 * IMG_BYTES, P_BYTES = 9216, L_F = L_P + 2 * P_BYTES, L_OX = L_F + 1024, OX_BYTES = 17408, P3_LDS_END = L_OX + 2 * OX_BYTES;
static_assert(P3_LDS_END <= LDSCTL_OFF, "P3 LDS map");
#define TR16(p) __builtin_amdgcn_ds_read_tr16_b64_v4i16((LAS s16x4*)(p))
__device__ __forceinline__ void p3_scan(const Args& a, LAS unsigned char* lds, int tid, int lane, int wave) {
    const int bxs = blockIdx.x, xq = bxs & 7, iq = bxs >> 3;
    const int job = (bxs >= 128) ? bxs : (iq < 8 ? 4 * (2 * xq + (iq >> 2)) + (iq & 3) : 64 + 2 * (4 * xq + ((iq - 8) >> 1)) + ((iq - 8) & 1));
    if (job < 128) {
        const bf16 *qp, *kp, *vp; const float *cmp_, *clp; bf16* op; int dir;
        { int colb, head, sl;
          if (job < 64) { const int seq = job >> 2; head = seq >> 1; sl = job & 3; dir = seq & 1; colb = head * 128;
              vp = (const bf16*)(a.ws + WS_GV) + head * 256 + sl * 64; op = (bf16*)(a.ws + (dir ? WS_OB : WS_OF)) + head * 256 + sl * 64; }
          else { const int jj = job - 64, seq = jj >> 1; head = seq >> 1; sl = jj & 1; dir = seq & 1; colb = 1024 + head * 128;
              vp = (const bf16*)(a.ws + WS_HI) + head * 128 + sl * 64; op = (bf16*)(a.ws + (dir ? WS_OB : WS_OF)) + 2048 + head * 128 + sl * 64; }
          qp = (const bf16*)(a.ws + (dir ? WS_QMB : WS_QMF)) + colb; kp = (const bf16*)(a.ws + (dir ? WS_KMB : WS_KMF)) + colb;
          cmp_ = (const float*)(a.ws + WS_CM) + (size_t)dir * 128 * NQK + colb; clp = (const float*)(a.ws + WS_CL) + (size_t)dir * 128 * NQK + colb; }
        const int prow = tid >> 4, pch = tid & 15;
        const int vs = tid >> 3, vo = tid & 7;
        v4u rq[2][2], rk[2][2], rv[2]; float rcm[2] = {0.f, 0.f}, rcl[2] = {0.f, 0.f};
#define P3_LOAD(S_, tau_) do { const int ci_ = dir ? 127 - (tau_) : (tau_); const size_t t0_ = (size_t)ci_ * 64; \
            _Pragma("unroll") for (int i_ = 0; i_ < 2; ++i_) { const size_t row_ = t0_ + prow + 32 * i_; \
                rq[S_][i_] = *(const GAS v4u*)(qp + row_ * NQK + 8 * pch); rk[S_][i_] = *(const GAS v4u*)(kp + row_ * NQK + 8 * pch); } \
            rv[S_] = __builtin_nontemporal_load((const GAS v4u*)(vp + (t0_ + vs) * 2048 + 8 * vo)); \
            if (tid < 128) { rcm[S_] = cmp_[(size_t)ci_ * NQK + tid]; rcl[S_] = clp[(size_t)ci_ * NQK + tid]; } } while (0)
        float carry = 0.f;
#define P3_STAGE(S_, tau_) do { LAS unsigned char* ib_ = lds + ((tau_) & 1) * IMG_BYTES; \
            _Pragma("unroll") for (int i_ = 0; i_ < 2; ++i_) { *(LAS v4u*)(ib_ + (prow + 32 * i_) * SQ_STR + 16 * pch) = rq[S_][i_]; *(LAS v4u*)(ib_ + IMG_KM + (prow + 32 * i_) * SQ_STR + 16 * pch) = rk[S_][i_]; } \
            *(LAS v4u*)(ib_ + IMG_V + vs * SV_STR + 16 * vo) = rv[S_]; \
            if (tid < 128) { ((LAS float*)(lds + L_F + ((tau_) & 1) * 512))[tid] = __expf(rcm[S_] + carry); carry = rcl[S_]; } } while (0)
        const int g = lane >> 4, c16 = lane & 15, cs = wave & 3, dh = wave >> 2, tq = c16 >> 2, tp = c16 & 3;
#define P3_SCORES(tau_) do { const LAS unsigned char* ib_ = lds + ((tau_) & 1) * IMG_BYTES; LAS unsigned char* pb_ = lds + L_P + ((tau_) & 1) * P_BYTES; \
            const int st = wave >> 1, tt0 = 2 * (wave & 1); f32x4 X0 = {0.f, 0.f, 0.f, 0.f}, X1 = {0.f, 0.f, 0.f, 0.f}; \
            _Pragma("unroll") for (int ks = 0; ks < 4; ++ks) { const bf16x8 A = *(const LAS bf16x8*)(ib_ + IMG_KM + (16 * st + c16) * SQ_STR + (32 * ks + 8 * g) * 2); \
                const bf16x8 B0 = *(const LAS bf16x8*)(ib_ + (16 * tt0 + c16) * SQ_STR + (32 * ks + 8 * g) * 2), B1 = *(const LAS bf16x8*)(ib_ + (16 * tt0 + 16 + c16) * SQ_STR + (32 * ks + 8 * g) * 2); \
                X0 = MFMA16(A, B0, X0); X1 = MFMA16(A, B1, X1); } \
            const int sb = 16 * st + 4 * g, ta = 16 * tt0 + c16, tb = ta + 16; \
            _Pragma("unroll") for (int i = 0; i < 4; ++i) { const int s = sb + i; const bool ka = dir ? (s >= ta) : (s <= ta), kb = dir ? (s >= tb) : (s <= tb); X0[i] = ka ? X0[i] : 0.f; X1[i] = kb ? X1[i] : 0.f; } \
            v2u w0, w1; w0.x = pkbf(X0[0], X0[1]); w0.y = pkbf(X0[2], X0[3]); w1.x = pkbf(X1[0], X1[1]); w1.y = pkbf(X1[2], X1[3]); \
            *(LAS v2u*)(pb_ + ta * SV_STR + sb * 2) = w0; *(LAS v2u*)(pb_ + tb * SV_STR + sb * 2) = w1; } while (0)
        f32x4 S[4];
#pragma unroll
        for (int n = 0; n < 4; ++n) S[n] = (f32x4){0.f, 0.f, 0.f, 0.f};
        P3_LOAD(0, 0); P3_STAGE(0, 0); P3_LOAD(1, 1); P3_LOAD(0, 2);
        __syncthreads();
        P3_SCORES(0);
        __syncthreads();
        for (int t2 = 0; t2 < 64; ++t2)
#pragma unroll
        for (int par = 0; par < 2; ++par) { const int tau = 2 * t2 + par;
            if (tau + 1 < 128) { P3_STAGE(1 - par, tau + 1); if (tau + 3 < 128) P3_LOAD(1 - par, tau + 3); }
            { const LAS unsigned char* ib = lds + (tau & 1) * IMG_BYTES; const LAS unsigned char* pb = lds + L_P + (tau & 1) * P_BYTES;
#pragma unroll
              for (int n = 0; n < 4; ++n) { const f32x4 f = *(const LAS f32x4*)(lds + L_F + (tau & 1) * 512 + (64 * dh + 16 * n + 4 * g) * 4); S[n] = S[n] * f; }
              bf16x8 vb[2];
#pragma unroll
              for (int ks = 0; ks < 2; ++ks) { const LAS unsigned char* va = ib + IMG_V + (32 * ks + 8 * g + tq) * SV_STR + 32 * cs + 8 * tp;
                  const s16x4 lo = TR16(va), hi = TR16(va + 4 * SV_STR); vb[ks] = __builtin_shufflevector(lo, hi, 0, 1, 2, 3, 4, 5, 6, 7); }
              f32x4 O[4];
#pragma unroll
              for (int m = 0; m < 4; ++m) O[m] = (f32x4){0.f, 0.f, 0.f, 0.f};
#pragma unroll
              for (int m = 0; m < 4; ++m) { const bf16x8 A = *(const LAS bf16x8*)(pb + (16 * m + c16) * SV_STR + (32 * dh + 8 * g) * 2); O[m] = MFMA16(dh ? vb[1] : vb[0], A, O[m]); }
#pragma unroll
              for (int p = 0; p < 2; ++p) { v4u bw; bw.x = pkbf(S[2 * p][0], S[2 * p][1]); bw.y = pkbf(S[2 * p][2], S[2 * p][3]); bw.z = pkbf(S[2 * p + 1][0], S[2 * p + 1][1]); bw.w = pkbf(S[2 * p + 1][2], S[2 * p + 1][3]);
                  const bf16x8 B = __builtin_bit_cast(bf16x8, bw);
#pragma unroll
                  for (int m = 0; m < 4; ++m) { const LAS unsigned char* qa = ib + (16 * m + c16) * SQ_STR + (64 * dh + 32 * p + 4 * g) * 2;
                      const v2u lo = *(const LAS v2u*)qa, hi = *(const LAS v2u*)(qa + 32); v4u aw; aw.x = lo.x; aw.y = lo.y; aw.z = hi.x; aw.w = hi.y;
                      O[m] = MFMA16(B, __builtin_bit_cast(bf16x8, aw), O[m]); } }
#pragma unroll
              for (int n = 0; n < 4; ++n)
#pragma unroll
                  for (int ks = 0; ks < 2; ++ks) { const LAS unsigned char* ka = ib + IMG_KM + (32 * ks + 8 * g + tq) * SQ_STR + (64 * dh + 16 * n) * 2 + 8 * tp;
                      const s16x4 lo = TR16(ka), hi = TR16(ka + 4 * SQ_STR);
                      S[n] = MFMA16(__builtin_shufflevector(lo, hi, 0, 1, 2, 3, 4, 5, 6, 7), vb[ks], S[n]); }
#pragma unroll
              for (int m = 0; m < 4; ++m) *(LAS f32x4*)(lds + L_OX + dh * OX_BYTES + ((16 * m + c16) * 68 + 16 * cs + 4 * g) * 4) = O[m];
            }
            __syncthreads();
            if (tau + 1 < 128) P3_SCORES(tau + 1);
            { const int ci = dir ? 127 - tau : tau; const size_t t0 = (size_t)ci * 64; const int row = tid >> 3, pc = tid & 7;
              const LAS float* x0 = (const LAS float*)(lds + L_OX) + row * 68 + 8 * pc; const LAS float* x1 = (const LAS float*)(lds + L_OX + OX_BYTES) + row * 68 + 8 * pc;
              const f32x4 a0 = *(const LAS f32x4*)x0 + *(const LAS f32x4*)x1, a1 = *(const LAS f32x4*)(x0 + 4) + *(const LAS f32x4*)(x1 + 4);
              v4u w; w.x = pkbf(a0[0], a0[1]); w.y = pkbf(a0[2], a0[3]); w.z = pkbf(a1[0], a1[1]); w.w = pkbf(a1[2], a1[3]);
              *(GAS v4u*)(op + (t0 + row) * 4096 + 8 * pc) = w; }
            __syncthreads();
        }
#undef P3_LOAD
#undef P3_STAGE
#undef P3_SCORES
        if (tid == 0) __hip_atomic_fetch_add((unsigned*)(a.ws + WS_CTL) + CW_P3DONE, 1u, __ATOMIC_RELAXED, __HIP_MEMORY_SCOPE_AGENT);
    } else {
        conv_queue_run(a, lds, tid, lane, wave, (const unsigned*)(a.ws + WS_CTL) + CW_P3DONE, 128u);
    }
}


__device__ __forceinline__ void p4_combine(const Args& a, int lane, int wave, int vcu, int G) {
    const int gw = vcu * NWAVES + wave, NGW = G * NWAVES;
    const bf16* OF = (const bf16*)(a.ws + WS_OF); const bf16* OB = (const bf16*)(a.ws + WS_OB);
    const bf16* GOG = (const bf16*)(a.ws + WS_GOG); const bf16* HOG = (const bf16*)(a.ws + WS_HOG); bf16* MX = (bf16*)(a.ws + WS_XN);
    const float* gw_ = a.in[7]; const float* hw_ = a.in[10];
    float wg[8], wh[8];
#pragma unroll
    for (int j = 0; j < 8; ++j) { wg[j] = gw_[8 * (lane & 31) + j]; wh[j] = hw_[8 * (lane & 15) + j]; }
    for (int row = gw; row < TT; row += NGW) {
#pragma unroll
        for (int c = 0; c < 8; ++c) {
            const size_t o = (size_t)row * DM + 512 * c + 8 * lane;
            const v4u vf = *(const GAS v4u*)(OF + o), vb = *(const GAS v4u*)(OB + o);
            const v4u og = (c < 4) ? *(const GAS v4u*)(GOG + (size_t)row * 2048 + 512 * c + 8 * lane) : *(const GAS v4u*)(HOG + (size_t)row * 2048 + 512 * (c - 4) + 8 * lane);
            float v[8]; float ss = 0.f;
#pragma unroll
            for (int j = 0; j < 4; ++j) { v[2 * j] = bflo(vf[j]) + bflo(vb[j]); v[2 * j + 1] = bfhi(vf[j]) + bfhi(vb[j]); ss += v[2 * j] * v[2 * j] + v[2 * j + 1] * v[2 * j + 1]; }
            ss += __shfl_xor(ss, 1); ss += __shfl_xor(ss, 2); ss += __shfl_xor(ss, 4); ss += __shfl_xor(ss, 8);
            float rs;
            if (c < 4) { ss += __shfl_xor(ss, 16); rs = 1.0f / sqrtf(ss * (1.f / 256.f) + EPS); } else rs = 1.0f / sqrtf(ss * (1.f / 128.f) + EPS);
            v4u w;
#pragma unroll
            for (int j = 0; j < 4; ++j) { const float w0 = (c < 4) ? wg[2 * j] : wh[2 * j], w1 = (c < 4) ? wg[2 * j + 1] : wh[2 * j + 1];
                w[j] = pkbf(v[2 * j] * rs * w0 * bflo(og[j]), v[2 * j + 1] * rs * w1 * bfhi(og[j])); }
            *(GAS v4u*)(MX + o) = w;
        }
    }
}

__device__ __forceinline__ void p6_router(const Args& a, LAS unsigned char* lds, int wave, int vcu, int G) {
    const bf16* H = (const bf16*)(a.ws + WS_H); const float* nw = a.in[12]; const bf16* WH = (const bf16*)(a.ws + WS_WRT); const bf16* WL = WH + NEXP * DM;
    unsigned char* XN2 = a.ws + WS_XN; float* AFFT = (float*)(a.ws + WS_AFFT);
    LAS f32x4* part = (LAS f32x4*)lds; LAS float* ssw = (LAS float*)(lds + 16384); LAS float* rsl = (LAS float*)(lds + 16384 + 1024);
    const __amdgpu_buffer_rsrc_t rsW = __builtin_amdgcn_make_buffer_rsrc((void*)WH, 0, 0x7fffffff, 0x00020000), rsN = __builtin_amdgcn_make_buffer_rsrc((void*)nw, 0, 0x7fffffff, 0x00020000);
    for (int blk = vcu; blk < TT / 32; blk += G) {
        const int r0 = blk * 32;
        const int lane = fresh_lane(), tid = wave * 64 + lane;
        const int i = lane & 15, kq = lane >> 4, kb = wave * 512 + kq * 8;
        const unsigned voff = (unsigned)((i * DM + kb) * 2);
        const __amdgpu_buffer_rsrc_t rsH = __builtin_amdgcn_make_buffer_rsrc((void*)(H + (size_t)r0 * DM), 0, 0x7fffffff, 0x00020000), rsX = __builtin_amdgcn_make_buffer_rsrc((void*)(XN2 + (size_t)r0 * DM), 0, 0x7fffffff, 0x00020000);
        v4u af[2][16];
#pragma unroll
        for (int t = 0; t < 2; ++t)
#pragma unroll
            for (int s_ = 0; s_ < 16; ++s_) af[t][s_] = __builtin_bit_cast(v4u, __builtin_amdgcn_raw_buffer_load_b128(rsH, voff, (unsigned)(t * 16 * DM * 2 + s_ * 64), 0));
        f32x4 acc[2] = {{0.f, 0.f, 0.f, 0.f}, {0.f, 0.f, 0.f, 0.f}};
        __builtin_amdgcn_sched_barrier(0);
#pragma unroll
        for (int hb = 0; hb < 4; ++hb) {
            v4u bh[4], bl[4];
#pragma unroll
            for (int s_ = 0; s_ < 4; ++s_) { bh[s_] = __builtin_bit_cast(v4u, __builtin_amdgcn_raw_buffer_load_b128(rsW, voff, (unsigned)((hb * 4 + s_) * 64), 0));
                bl[s_] = __builtin_bit_cast(v4u, __builtin_amdgcn_raw_buffer_load_b128(rsW, voff, (unsigned)(NEXP * DM * 2 + (hb * 4 + s_) * 64), 0)); }
#pragma unroll
            for (int s_ = 0; s_ < 4; ++s_)
#pragma unroll
                for (int t = 0; t < 2; ++t) { acc[t] = __builtin_amdgcn_mfma_f32_16x16x32_bf16(__builtin_bit_cast(bf16x8, bh[s_]), __builtin_bit_cast(bf16x8, af[t][hb * 4 + s_]), acc[t], 0, 0, 0);
                    acc[t] = __builtin_amdgcn_mfma_f32_16x16x32_bf16(__builtin_bit_cast(bf16x8, bl[s_]), __builtin_bit_cast(bf16x8, af[t][hb * 4 + s_]), acc[t], 0, 0, 0); }
            __builtin_amdgcn_sched_barrier(0);
        }
#pragma unroll
        for (int t = 0; t < 2; ++t) { float ss = 0.f;
#pragma unroll
            for (int s_ = 0; s_ < 16; ++s_) { const v4u w = af[t][s_];
#pragma unroll
                for (int j = 0; j < 4; ++j) { const float x0 = bflo(w[j]), x1 = bfhi(w[j]); ss = fmaf(x0, x0, ss); ss = fmaf(x1, x1, ss); } }
            ss += __shfl_xor(ss, 16); ss += __shfl_xor(ss, 32);
            if (lane < 16) ssw[wave * 32 + t * 16 + lane] = ss;
            part[(wave * 2 + t) * 64 + lane] = acc[t]; }
        __syncthreads();
        { const int tok = tid >> 4, e = tid & 15, t = tok >> 4, src = (e >> 2) * 16 + (tok & 15);
          float lg = 0.f, ss = 0.f;
#pragma unroll
          for (int w = 0; w < 8; ++w) { lg += ((const LAS float*)(part + (w * 2 + t) * 64 + src))[e & 3]; ss += ssw[w * 32 + tok]; }
          const float rstd = 1.0f / sqrtf(ss * (1.f / DM) + EPS);
          lg *= rstd; float mx = lg;
          mx = fmaxf(mx, __shfl_xor(mx, 1)); mx = fmaxf(mx, __shfl_xor(mx, 2)); mx = fmaxf(mx, __shfl_xor(mx, 4)); mx = fmaxf(mx, __shfl_xor(mx, 8));
          const float ex = expf(lg - mx); float den = ex;
          den += __shfl_xor(den, 1); den += __shfl_xor(den, 2); den += __shfl_xor(den, 4); den += __shfl_xor(den, 8);
          AFFT[(size_t)e * TT + r0 + tok] = ex * (1.0f / den);
          if (e == 0) rsl[tok] = rstd; }
        __syncthreads();
#pragma unroll
        for (int t = 0; t < 2; ++t)
#pragma unroll
            for (int s_ = 0; s_ < 16; ++s_) asm volatile("" : "+v"(af[t][s_]));
#pragma unroll
        for (int t = 0; t < 2; ++t) { const float rs = rsl[t * 16 + i];
#pragma unroll
            for (int s_ = 0; s_ < 16; ++s_) { if ((s_ & 3) == 0) __builtin_amdgcn_sched_barrier(0);
                const v4u w = af[t][s_]; const f32x4 n0 = __builtin_bit_cast(f32x4, __builtin_amdgcn_raw_buffer_load_b128(rsN, (unsigned)(kb * 4), (unsigned)(s_ * 128), 0)), n1 = __builtin_bit_cast(f32x4, __builtin_amdgcn_raw_buffer_load_b128(rsN, (unsigned)(kb * 4), (unsigned)(s_ * 128 + 16), 0));
                v2u o; o.x = pk4_fp8(bflo(w[0]) * rs * n0.x, bfhi(w[0]) * rs * n0.y, bflo(w[1]) * rs * n0.z, bfhi(w[1]) * rs * n0.w);
                o.y = pk4_fp8(bflo(w[2]) * rs * n1.x, bfhi(w[2]) * rs * n1.y, bflo(w[3]) * rs * n1.z, bfhi(w[3]) * rs * n1.w);
                __builtin_amdgcn_raw_buffer_store_b64(o, rsX, voff >> 1, (unsigned)(t * 16 * DM + s_ * 32), 0); } }
        __syncthreads();
    }
}

__device__ __forceinline__ void p7_topk(const Args& a, LAS unsigned char* lds, int tid, int lane, int wave) {
    if (blockIdx.x < NEXP) {
        const int e = blockIdx.x; const float* AFFT = (const float*)(a.ws + WS_AFFT) + (size_t)e * TT;
        int* IDX = (int*)(a.ws + WS_IDX) + e * CAP; float* GATEV = (float*)(a.ws + WS_GATEV) + e * CAP; int* SLOT = (int*)(a.ws + WS_SLOT); unsigned short* PAIR = (unsigned short*)(a.ws + WS_PAIR) + e * (8 * 64 * 2);
        volatile LAS int* cnt = (volatile LAS int*)lds;
        unsigned u[16];
#pragma unroll
        for (int j = 0; j < 16; ++j) u[j] = __builtin_bit_cast(unsigned, AFFT[tid + 512 * j]);
        unsigned thr = 0u;
        for (int bit = 30; bit >= 0; --bit) {
            const unsigned cand = thr | (1u << bit); int c = 0;
#pragma unroll
            for (int j = 0; j < 16; ++j) c += __popcll(__ballot(u[j] >= cand));
            if (lane == 0) cnt[(bit & 1) * 8 + wave] = c;
            __syncthreads();
            int tot = 0;
#pragma unroll
            for (int w = 0; w < 8; ++w) tot += cnt[(bit & 1) * 8 + w];
            if (tot >= CAP) thr = cand;
        }
        __syncthreads();
        { int c = 0;
#pragma unroll
          for (int j = 0; j < 16; ++j) c += __popcll(__ballot(u[j] > thr));
          if (lane == 0) cnt[wave] = c; }
        __syncthreads();
        int n_gt = 0;
#pragma unroll
        for (int w = 0; w < 8; ++w) n_gt += cnt[w];
        const int need_eq = CAP - n_gt;
        __syncthreads();
        int base_gt = 0, base_eq = 0; const unsigned long long lt = (1ull << lane) - 1ull;
        for (int j = 0; j < 16; ++j) {
            const bool gt = u[j] > thr, eq = u[j] == thr;
            const unsigned long long bg = __ballot(gt), be = __ballot(eq);
            volatile LAS int* pb = cnt + 16 + (j & 1) * 16;
            if (lane == 0) { pb[wave] = __popcll(bg); pb[8 + wave] = __popcll(be); }
            __syncthreads();
            int wg_ = 0, we = 0, tg = 0, te = 0;
#pragma unroll
            for (int w = 0; w < 8; ++w) { const int cg = pb[w], ce = pb[8 + w]; if (w < wave) { wg_ += cg; we += ce; } tg += cg; te += ce; }
            const int gt_before = base_gt + wg_ + __popcll(bg & lt), eq_before = base_eq + we + __popcll(be & lt);
            const bool sel = gt || (eq && eq_before < need_eq);
            const int pos = gt_before + (eq_before < need_eq ? eq_before : need_eq);
            const int t = tid + 512 * j;
            if (sel) { IDX[pos] = t; GATEV[pos] = __builtin_bit_cast(float, u[j]); PAIR[(((pos >> 7) * 64 + (pos & 63)) << 1) + ((pos >> 6) & 1)] = (unsigned short)t; }
            SLOT[(size_t)t * 16 + e] = sel ? pos : -1;
            base_gt += tg; base_eq += te;
        }
        __syncthreads();
        if (tid == 0) __hip_atomic_fetch_add((unsigned*)(a.ws + WS_CTL) + CW_P7DONE, 1u, __ATOMIC_RELAXED, __HIP_MEMORY_SCOPE_AGENT);
    } else {
        conv_queue_run(a, lds, tid, lane, wave, (const unsigned*)(a.ws + WS_CTL) + CW_P7DONE, (unsigned)NEXP);
    }
}

__device__ __forceinline__ void p8_gather(const Args& a, int lane, int wave, int vcu, int G) {
    const int gw = vcu * NWAVES + wave, NGW = G * NWAVES;
    const unsigned char* XN2 = a.ws + WS_XN; unsigned char* XE = a.ws + WS_XE; const int* IDX = (const int*)(a.ws + WS_IDX);
    for (int r = gw; r < NEXP * CAP; r += NGW) { const int t = IDX[r]; const GAS v4u* s = (const GAS v4u*)(XN2 + (size_t)t * DM) + lane; GAS v4u* d = (GAS v4u*)(XE + (size_t)r * DM) + lane;
        v4u v[4];
#pragma unroll
        for (int j = 0; j < 4; ++j) v[j] = s[64 * j];
#pragma unroll
        for (int j = 0; j < 4; ++j) d[64 * j] = v[j]; }
}

__device__ __forceinline__ void p11_final(const Args& a, int lane, int wave, int vcu, int G) {
    const int gw = vcu * NWAVES + wave, NGW = G * NWAVES;
    const bf16* H = (const bf16*)(a.ws + WS_H); const bf16* YE = (const bf16*)(a.ws + WS_YE); const int* SLOT = (const int*)(a.ws + WS_SLOT); const float* nw = a.in[17];
    for (int row = gw; row < TT; row += NGW) {
        const int myslot = (lane < NEXP) ? SLOT[(size_t)row * 16 + lane] : -1;
        v2u hb[16];
#pragma unroll
        for (int j = 0; j < 16; ++j) hb[j] = *(const GAS v2u*)(H + (size_t)row * DM + 256 * j + 4 * lane);
        unsigned mask = (unsigned)(__ballot(myslot >= 0) & 0xffffull);
        f32x4 v[16];
#pragma unroll
        for (int j = 0; j < 16; ++j) v[j] = (f32x4){bflo(hb[j].x), bfhi(hb[j].x), bflo(hb[j].y), bfhi(hb[j].y)};
        while (mask) {
            const int e0 = __builtin_ctz(mask); mask &= mask - 1u; const bool two = mask != 0u; const int e1 = two ? __builtin_ctz(mask) : e0; if (two) mask &= mask - 1u;
            const int s0 = __builtin_amdgcn_readlane(myslot, e0), s1 = __builtin_amdgcn_readlane(myslot, e1);
            const bf16* y0 = YE + ((size_t)e0 * CAP + s0) * DM; const bf16* y1 = YE + ((size_t)e1 * CAP + s1) * DM;
            v2u w0[16], w1[16];
#pragma unroll
            for (int j = 0; j < 16; ++j) { w0[j] = *(const GAS v2u*)(y0 + 256 * j + 4 * lane); w1[j] = *(const GAS v2u*)(y1 + 256 * j + 4 * lane); }
            const float f1 = two ? 1.f : 0.f;
#pragma unroll
            for (int j = 0; j < 16; ++j) { v[j].x += bflo(w0[j].x) + f1 * bflo(w1[j].x); v[j].y += bfhi(w0[j].x) + f1 * bfhi(w1[j].x); v[j].z += bflo(w0[j].y) + f1 * bflo(w1[j].y); v[j].w += bfhi(w0[j].y) + f1 * bfhi(w1[j].y); }
        }
        float s = 0.f;
#pragma unroll
        for (int j = 0; j < 16; ++j) s += (v[j].x * v[j].x + v[j].y * v[j].y) + (v[j].z * v[j].z + v[j].w * v[j].w);
        const float rstd = 1.0f / sqrtf(wave_sum(s) * (1.f / DM) + EPS);
#pragma unroll
        for (int j = 0; j < 16; ++j) { const f32x4 ww = *(const GAS f32x4*)(nw + 256 * j + 4 * lane); *(GAS f32x4*)(a.out + (size_t)row * DM + 256 * j + 4 * lane) = v[j] * rstd * ww; }
    }
}

__global__ void __launch_bounds__(NWAVES * 64, 2) mk_fwd(Args args) {
    extern __shared__ __attribute__((aligned(16))) unsigned char lds_raw[];
    LAS unsigned char* lds = (LAS unsigned char*)lds_raw;
    const int tid0 = threadIdx.x, wave = __builtin_amdgcn_readfirstlane(tid0 >> 6);
#define FRESH_IDS const int lane = fresh_lane(), tid = wave * 64 + lane; (void)tid; (void)lane
    const int G = gridDim.x; const int bx = blockIdx.x; const int vcu = (G % 8 == 0) ? (bx % 8) * (G / 8) + bx / 8 : bx;
    for (int u = tid0; u < (LDS_BYTES - LDSCTL_OFF) / 4; u += NWAVES * 64) ((LAS unsigned*)(lds + LDSCTL_OFF))[u] = 0u;
    __syncthreads();
    XcdBarrier bar = xcd_barrier_post((unsigned*)(args.ws + WS_CTL) + CW_BAR, (volatile LAS unsigned*)(lds + MISC_OFF) + 8);
    const int lo = args.ph_lo, hi = args.ph_hi;
#define IN(k) (lo <= (k) && (k) < hi)
#define SEAM(k) do { if (IN(k) && hi > (k) + 1) xcd_barrier(bar); } while (0)
    if (IN(0)) REP(0) { FRESH_IDS; p0_prologue(args, lds, lane, wave, vcu, G); } SEAM(0);
    if (IN(1)) { FRESH_IDS;
        p1_glow(args, lds, tid, lane, wave);
        pg8::Gemm g{(const pg8::bf16_t*)(args.ws + WS_XN), (const pg8::bf16_t*)(args.ws + WS_WINT), TT, NPROJ, DM}; pg8::StaticOrder S; S.init(TT, NPROJ, G, bx);
        pg8::EpiInProj E{args.ws};
        pg8::gemm_phase<pg8::EpiInProj, pg8::StaticOrder, true, true>(lds, g, S, E, wave);
#if (PROBE_MASK >> 1) & 1
        pg8::gemm_phase<pg8::EpiInProj, pg8::StaticOrder, true, true>(lds, g, S, E, wave);
#endif
    } SEAM(1);
    if (IN(2)) REP(2) { FRESH_IDS; p2_prep(args, lds, tid); } SEAM(2);
    if (IN(3)) REP(3) { FRESH_IDS; p3_scan(args, lds, tid, lane, wave); } SEAM(3);
    if (IN(4)) REP(4) { FRESH_IDS; p4_combine(args, lane, wave, vcu, G); } SEAM(4);
    if (IN(5)) { FRESH_IDS;
        pg8::Gemm g{(const pg8::bf16_t*)(args.ws + WS_XN), (const pg8::bf16_t*)(args.ws + WS_WOUTT), TT, DM, DM}; pg8::StaticOrder S; S.init(TT, DM, G, bx);
        pg8::EpiResBf16 E{args.in[0], (pg8::bf16_t*)(args.ws + WS_H), DM};
        pg8::gemm_phase<pg8::EpiResBf16, pg8::StaticOrder, true, true>(lds, g, S, E, wave);
#if (PROBE_MASK >> 5) & 1
        pg8::gemm_phase<pg8::EpiResBf16, pg8::StaticOrder, true, true>(lds, g, S, E, wave);
#endif
    } SEAM(5);
    if (IN(6)) REP(6) { FRESH_IDS; p6_router(args, lds, wave, vcu, G); } SEAM(6);
    if (IN(7)) REP(7) { FRESH_IDS; p7_topk(args, lds, tid, lane, wave); conv_queue_run(args, lds, tid, lane, wave, nullptr, 0u); } SEAM(7);
    if (IN(9)) { FRESH_IDS;
        pg8::Gemm g{(const pg8::bf16_t*)(args.ws + WS_XN), (const pg8::bf16_t*)(args.ws + WS_W13T), NEXP * CAP, 4096, DM, (const int*)(args.ws + WS_PAIR)}; pg8::GroupedOrder S{bx};
        pg8::EpiSwiglu E{args.ws + WS_HID};
        pg8::gemm_phase<pg8::EpiSwiglu, pg8::GroupedOrder, true, true, true, true>(lds, g, S, E, wave);
#if (PROBE_MASK >> 9) & 1
        pg8::gemm_phase<pg8::EpiSwiglu, pg8::GroupedOrder, true, true, true, true>(lds, g, S, E, wave);
#endif
    } SEAM(9);
    if (IN(10)) { FRESH_IDS;
        pg8::Gemm g{(const pg8::bf16_t*)(args.ws + WS_HID), (const pg8::bf16_t*)(args.ws + WS_W2T), NEXP * CAP, 4096, DEXP}; pg8::GroupedOrder S{bx};
        pg8::EpiGate E{(pg8::bf16_t*)(args.ws + WS_YE), (const float*)(args.ws + WS_GATEV)};
        pg8::gemm_phase<pg8::EpiGate, pg8::GroupedOrder, true, true, false, true>(lds, g, S, E, wave);
#if (PROBE_MASK >> 10) & 1
        pg8::gemm_phase<pg8::EpiGate, pg8::GroupedOrder, true, true, false, true>(lds, g, S, E, wave);
#endif
    } SEAM(10);
    if (IN(11)) REP(11) { FRESH_IDS; p11_final(args, lane, wave, vcu, G); }
#undef IN
#undef SEAM
}

extern "C" void kernel_launch(void* const* d_in, const int* in_sizes, int n_in, void* d_out, int out_size, void* d_ws, size_t ws_size, hipStream_t stream) {
    static int grid = 0;
    if (grid == 0) {
        if (n_in != 18 || out_size != TT * DM || ws_size < WS_END) { fprintf(stderr, "kernel_launch: unexpected shapes (n_in %d, out %d, ws %zu < %zu)\n", n_in, out_size, ws_size, (size_t)WS_END); grid = -1; return; }
        int dev = 0, cus = 0, per_cu = 0;
        if (hipGetDevice(&dev) != hipSuccess || hipDeviceGetAttribute(&cus, hipDeviceAttributeMultiprocessorCount, dev) != hipSuccess) { grid = -1; return; }
        if (hipFuncSetAttribute((const void*)mk_fwd, hipFuncAttributeMaxDynamicSharedMemorySize, LDS_BYTES) != hipSuccess) { fprintf(stderr, "kernel_launch: hipFuncSetAttribute failed\n"); grid = -1; return; }
        if (hipOccupancyMaxActiveBlocksPerMultiprocessor(&per_cu, (const void*)mk_fwd, NWAVES * 64, LDS_BYTES) != hipSuccess || per_cu < 1) fprintf(stderr, "kernel_launch: occupancy query reports %d\n", per_cu);
        (void)hipGetLastError();
        grid = cus;
        if (grid != 256) fprintf(stderr, "kernel_launch: %d CUs (built for 256)\n", grid);
    }
    if (grid < 0) return;
    (void)hipMemsetAsync((char*)d_ws + WS_CTL, 0, CTL_ZERO_BYTES, stream);
    Args a{};
    for (int i = 0; i < 18; ++i) a.in[i] = (const float*)d_in[i];
    a.out = (float*)d_out; a.ws = (unsigned char*)d_ws;
#if MK_ONE_LAUNCH
    a.ph_lo = 0; a.ph_hi = N_PHASES;
    hipLaunchKernelGGL(mk_fwd, dim3(grid), dim3(NWAVES * 64), LDS_BYTES, stream, a);
#else
    for (int p = 0; p < N_PHASES; ++p) { a.ph_lo = p; a.ph_hi = p + 1; hipLaunchKernelGGL(mk_fwd, dim3(grid), dim3(NWAVES * 64), LDS_BYTES, stream, a); }
#endif
}
```
